# Optimizing an MI355X kernel written in HIP

```python
import math
import jax, jax.numpy as jnp
from jax import lax
import numpy as np

D_MODEL = 1024
BATCH = 16
SEQ = 256
DEPTH = 2
DEC_BATCH = 4
DEC_SEQ = 2048
PAST_LEN = 512

GRID_W = 64
MIX_W = D_MODEL
FOURIER_W = MIX_W // 4
CONV_W = MIX_W // 4
ATTN_W = MIX_W // 2
N_HEADS = 4
HEAD_DIM = ATTN_W // (2 * N_HEADS)
QK_W = 2 * HEAD_DIM
CONV_K = 3
ROPE_BASE = 10000.0
Q_BLOCK = 128
EPS = 1e-6
IN_DIM = 2 * FOURIER_W + 4 * CONV_W + 4 * ATTN_W

kernel_name = "hybrid_fourier_conv_diffattn_dit_step"


def _split_points():
    sizes = [FOURIER_W, FOURIER_W, CONV_W, CONV_W, CONV_W, CONV_W, ATTN_W, ATTN_W, ATTN_W]
    return [int(s) for s in np.cumsum(sizes)]


def _rmsnorm(x, g):
    xf = x.astype(jnp.float32)
    y = xf * lax.rsqrt(jnp.mean(xf * xf, axis=-1, keepdims=True) + EPS)
    return (y * g.astype(jnp.float32)).astype(x.dtype)


def _fourier(u):
    f = jnp.fft.fft2(u.astype(jnp.float32), axes=(1, 2), norm="ortho")
    return jnp.real(f).astype(u.dtype)


def _short_conv(b_gate, c_gate, h, w, bias):
    z = c_gate * h
    n = z.shape[1]
    zp = jnp.pad(z, ((0, 0), (1, 1), (0, 0)))
    y = zp[:, 0:n] * w[0] + zp[:, 1:n + 1] * w[1] + zp[:, 2:n + 2] * w[2] + bias
    return b_gate * y


def _rope_axis(t, pos):
    r = t.shape[-1]
    half = r // 2
    inv = 1.0 / (ROPE_BASE ** (jnp.arange(0, r, 2, dtype=jnp.float32) / r))
    ang = pos.astype(jnp.float32)[:, None] * inv[None, :]
    ang = jnp.concatenate([ang, ang], axis=-1)
    cos = jnp.cos(ang)[None, :, None, None, :]
    sin = jnp.sin(ang)[None, :, None, None, :]
    tf = t.astype(jnp.float32)
    rot = jnp.concatenate([-tf[..., half:], tf[..., :half]], axis=-1)
    return (tf * cos + rot * sin).astype(t.dtype)


def _rope_2d(t, row, col):
    b, n, h, _ = t.shape
    t = t.reshape(b, n, h, 2, HEAD_DIM)
    half = HEAD_DIM // 2
    tr = _rope_axis(t[..., :half], row)
    tc = _rope_axis(t[..., half:], col)
    return jnp.concatenate([tr, tc], axis=-1).reshape(b, n, h, QK_W)


def _diff_attention(q, k, v, lam):
    b, n, h, _ = q.shape
    nb = n // Q_BLOCK
    scale = HEAD_DIM ** -0.5
    k1 = k[..., :HEAD_DIM]
    k2 = k[..., HEAD_DIM:]
    qb = q.reshape(b, nb, Q_BLOCK, h, QK_W).transpose(1, 0, 2, 3, 4)

    def block(qblk):
        s1 = jnp.einsum('bqhd,bkhd->bhqk', qblk[..., :HEAD_DIM], k1,
                        preferred_element_type=jnp.float32) * scale
        s2 = jnp.einsum('bqhd,bkhd->bhqk', qblk[..., HEAD_DIM:], k2,
                        preferred_element_type=jnp.float32) * scale
        p = jax.nn.softmax(s1, axis=-1) - lam * jax.nn.softmax(s2, axis=-1)
        return jnp.einsum('bhqk,bkhd->bqhd', p.astype(v.dtype), v)

    o = lax.map(block, qb)
    return o.transpose(1, 0, 2, 3, 4).reshape(b, n, h, v.shape[-1])


def _layer(x, mod, norm_g, w_in, conv_w, conv_b, lam_vec, subln_g, w_out,
           layer_idx, pos, ctx_kv):
    shift, scale, gate = jnp.split(mod, 3, axis=-1)
    h = _rmsnorm(x, norm_g) * (1.0 + scale) + shift
    z = h @ w_in
    fa, ga, bg, cg, hc, gb, q, k, v, gc = jnp.split(z, _split_points(), axis=-1)
    b, n, _ = x.shape
    ya = _fourier(fa) * jax.nn.silu(ga)
    yb = _short_conv(bg, cg, hc, conv_w, conv_b) * jax.nn.silu(gb)
    q = q.reshape(b, n, N_HEADS, QK_W)
    k = k.reshape(b, n, N_HEADS, QK_W)
    v = v.reshape(b, n, N_HEADS, QK_W)
    if pos is not None:
        q = _rope_2d(q, pos[0], pos[1])
        k = _rope_2d(k, pos[0], pos[1])
    if ctx_kv is not None:
        keys = jnp.concatenate([ctx_kv[0].astype(k.dtype), k], axis=1)
        vals = jnp.concatenate([ctx_kv[1].astype(v.dtype), v], axis=1)
    else:
        keys, vals = k, v
    lam_init = 0.8 - 0.6 * math.exp(-0.3 * layer_idx)
    lv = lam_vec.astype(jnp.float32)
    lam = jnp.exp(jnp.sum(lv[0] * lv[1])) - jnp.exp(jnp.sum(lv[2] * lv[3])) + lam_init
    o = _diff_attention(q, keys, vals, lam)
    o = _rmsnorm(o, subln_g) * (1.0 - lam_init)
    yc = o.reshape(b, n, ATTN_W) * jax.nn.silu(gc)
    out = jnp.concatenate([ya, yb, yc], axis=-1) @ w_out
    return x + gate * out, k, v


def setup_inputs(seed: int = 0) -> dict:
    key = jax.random.key(seed)
    ks = jax.random.split(key, 16)
    f32 = jnp.float32
    nrm = lambda k, s: jax.random.normal(k, s, dtype=f32)
    return {
        "x_prompt": nrm(ks[0], (BATCH, SEQ, D_MODEL)),
        "x_sample": nrm(ks[1], (DEC_BATCH, DEC_SEQ, D_MODEL)),
        "cache_k": nrm(ks[2], (DEC_BATCH, DEPTH, PAST_LEN, N_HEADS, QK_W)),
        "cache_v": nrm(ks[3], (DEC_BATCH, DEPTH, PAST_LEN, N_HEADS, QK_W)),
        "c": nrm(ks[4], (DEC_BATCH, D_MODEL)),
        "c_ctx": nrm(ks[5], (D_MODEL,)),
        "norm_g": 1.0 + 0.02 * nrm(ks[6], (DEPTH, D_MODEL)),
        "w_mod": nrm(ks[7], (DEPTH, D_MODEL, 3 * D_MODEL)) * D_MODEL ** -0.5,
        "b_mod": 0.02 * nrm(ks[8], (DEPTH, 3 * D_MODEL)),
        "w_in": nrm(ks[9], (DEPTH, D_MODEL, IN_DIM)) * D_MODEL ** -0.5,
        "conv_w": nrm(ks[10], (DEPTH, CONV_K, CONV_W)) * CONV_K ** -0.5,
        "conv_b": 0.02 * nrm(ks[11], (DEPTH, CONV_W)),
        "lam_vec": 0.1 * nrm(ks[12], (DEPTH, 4, HEAD_DIM)),
        "subln_g": 1.0 + 0.02 * nrm(ks[13], (DEPTH, QK_W)),
        "w_out": nrm(ks[14], (DEPTH, MIX_W, D_MODEL)) * MIX_W ** -0.5,
        "final_g": 1.0 + 0.02 * nrm(ks[15], (D_MODEL,)),
    }


def reference(x_prompt, x_sample, cache_k, cache_v, c, c_ctx, norm_g, w_mod, b_mod,
              w_in, conv_w, conv_b, lam_vec, subln_g, w_out, final_g):
    xc = x_prompt
    sc = jax.nn.silu(c_ctx)
    ks, vs = [], []
    for l in range(DEPTH):
        mod = sc @ w_mod[l] + b_mod[l]
        xc, kl, vl = _layer(xc, mod, norm_g[l], w_in[l], conv_w[l], conv_b[l],
                            lam_vec[l], subln_g[l], w_out[l], l, None, None)
        ks.append(kl)
        vs.append(vl)
    y_prompt = _rmsnorm(xc, final_g)
    new_k = jnp.stack(ks, axis=1)
    new_v = jnp.stack(vs, axis=1)

    n = x_sample.shape[1]
    rows = n // GRID_W
    row = jnp.repeat(jnp.arange(rows, dtype=jnp.int32), GRID_W)
    col = jnp.tile(jnp.arange(GRID_W, dtype=jnp.int32), rows)
    sl = jax.nn.silu(c)
    xl = x_sample
    for l in range(DEPTH):
        mod = (sl @ w_mod[l] + b_mod[l])[:, None, :]
        xl, _, _ = _layer(xl, mod, norm_g[l], w_in[l], conv_w[l], conv_b[l],
                          lam_vec[l], subln_g[l], w_out[l], l, (row, col),
                          (cache_k[:, l], cache_v[:, l]))
    y_sample = _rmsnorm(xl, final_g)
    return (y_prompt, y_sample, new_k, new_v)
```

```cpp
#include <hip/hip_runtime.h>
#include <cstdio>
#include <cstdint>
#define LAS __attribute__((address_space(3)))
typedef unsigned short u16;
typedef unsigned u32x4 __attribute__((ext_vector_type(4)));
typedef unsigned u32x2 __attribute__((ext_vector_type(2)));
typedef float f32x4 __attribute__((ext_vector_type(4)));
typedef float f32x2 __attribute__((ext_vector_type(2)));
typedef float f32x16 __attribute__((ext_vector_type(16)));
typedef short bf16x8 __attribute__((ext_vector_type(8)));
typedef short s16x4 __attribute__((ext_vector_type(4)));

constexpr int DM = 1024, NCTX = 4096, NSMP = 8192, NTOK = 12288, CTX_SEQ = 256, SMP_SEQ = 2048, PAST = 512;
constexpr int INDIM = 3584, NMAIN = 3328, NFT = 512;
constexpr float EPS = 1e-6f;
constexpr float QSCALE = 0.125f * 1.4426950408889634f;
constexpr size_t OUT_YP = 0, OUT_YS = 4194304, OUT_NK = 12582912, OUT_NV = 16777216, OUT_TOTAL = 20971520;

constexpr size_t MiB = 1u << 20;
constexpr size_t WS_CTL = 0;
constexpr size_t WS_WMT = 1 * MiB;
constexpr size_t WS_WFT = 14 * MiB;
constexpr size_t WS_WOT = 16 * MiB;
constexpr size_t WS_CK = 20 * MiB;
constexpr size_t WS_CV = 24 * MiB;
constexpr size_t WS_DS = 28 * MiB;
constexpr size_t WS_DC = 44 * MiB;
constexpr size_t WS_MOD = 44 * MiB + 512 * 1024;
constexpr size_t WS_SW = 44 * MiB + 768 * 1024;
constexpr size_t WS_SWF = 45 * MiB;
constexpr size_t WS_ROPE = 45 * MiB + 64 * 1024;
constexpr size_t WS_LAM = 45 * MiB + 128 * 1024;
constexpr size_t WS_PART = 46 * MiB;
constexpr size_t WS_AP = 47 * MiB;
constexpr size_t WS_XTS = 71 * MiB;
constexpr size_t WS_XTC = 79 * MiB;
constexpr size_t WS_SGA = 83 * MiB;
constexpr size_t WS_U = 89 * MiB;
constexpr size_t WS_WC = 95 * MiB;
constexpr size_t WS_Q = 101 * MiB;
constexpr size_t WS_K = 113 * MiB;
constexpr size_t WS_V = 125 * MiB;
constexpr size_t WS_SGC = 137 * MiB;
constexpr size_t WS_YMIX = 149 * MiB;
constexpr size_t WS_X1 = 173 * MiB;
constexpr size_t WS_END = 221 * MiB;
constexpr int CW_BAR = 4096;
constexpr int CW_QUEUE = 8192;

__device__ __forceinline__ unsigned f2bf(float f) { unsigned u = __builtin_bit_cast(unsigned, f); return (u + 0x7fffu + ((u >> 16) & 1u)) >> 16; }
__device__ __forceinline__ unsigned pk2(float lo, float hi) { return f2bf(lo) | (f2bf(hi) << 16); }
__device__ __forceinline__ float bflo(unsigned u) { return __builtin_bit_cast(float, u << 16); }
__device__ __forceinline__ float bfhi(unsigned u) { return __builtin_bit_cast(float, u & 0xffff0000u); }
__device__ __forceinline__ float bf2f(u16 h) { return __builtin_bit_cast(float, (unsigned)h << 16); }
__device__ __forceinline__ float silu(float x) { return x / (1.f + __expf(-x)); }
__device__ __forceinline__ float wave_sum(float v) {
#pragma unroll
    for (int o = 1; o < 64; o <<= 1) v += __shfl_xor(v, o);
    return v;
}
__device__ __forceinline__ float wave_max(float v) {
#pragma unroll
    for (int o = 1; o < 64; o <<= 1) v = fmaxf(v, __shfl_xor(v, o));
    return v;
}
__device__ __forceinline__ int modid(int r) { return r < NCTX ? 0 : 1 + ((r - NCTX) >> 11); }
__device__ __forceinline__ int o8(int jj) { const int bj = jj >> 7, wc = (jj >> 5) & 3, n = (jj >> 4) & 1, fq = (jj >> 2) & 3, e = jj & 3; return 128 * bj + 32 * wc + 8 * fq + 4 * n + e; }
__device__ __forceinline__ int inv_o8(int o) { const int bj = o >> 7, wc = (o >> 5) & 3, fq = (o >> 3) & 3, n = (o >> 2) & 1, e = o & 3; return 128 * bj + 32 * wc + 16 * n + 4 * fq + e; }
__device__ __forceinline__ int orig_col(int j) {
    const int T = j >> 8, jj = j & 255;
    if (T == 0) return 256 + o8(jj);
    if (T <= 4) { const int bj = jj >> 7, wc = (jj >> 5) & 3, n = (jj >> 4) & 1, fq = (jj >> 2) & 3, e = jj & 3; return 512 + 256 * (bj * 2 + n) + (T - 1) * 64 + 16 * wc + 4 * fq + e; }
    if (T <= 6) return 1536 + (T - 5) * 256 + jj;
    if (T <= 8) return 2048 + (T - 7) * 256 + jj;
    if (T <= 10) return 2560 + (T - 9) * 256 + o8(jj);
    return 3072 + (T - 11) * 256 + o8(jj);
}
__device__ __forceinline__ int tile_col(int o) {
    if (o < 512) return inv_o8(o - 256);
    if (o < 1536) { const int grp = (o - 512) >> 8, ch = (o - 512) & 255, t = ch >> 6, c6 = ch & 63, wc = c6 >> 4, fq = (c6 >> 2) & 3, e = c6 & 3; return 256 * (1 + t) + 128 * (grp >> 1) + 32 * wc + 16 * (grp & 1) + 4 * fq + e; }
    if (o < 2048) return 1280 + (o - 1536);
    if (o < 2560) return 1792 + (o - 2048);
    if (o < 3072) { const int c = o - 2560; return 2304 + (c >> 8) * 256 + inv_o8(c & 255); }
    { const int c = o - 3072; return 2816 + (c >> 8) * 256 + inv_o8(c & 255); }
}

#define XB_TMO      128
#define XB_XCNT(j)  (256  + 64 * (j))
#define XB_XSUB(j)  (1280 + 64 * (j))
#define XB_XGEN(j)  (2304 + 64 * (j))
#define XB_TOP      3328
#define XB_TOPGEN   3392
#define XCD_BAR_WORDS 3456
#define XB_SPIN_CAP (1u << 18)
__device__ __forceinline__ unsigned xb_ld(unsigned* p)              { return __hip_atomic_load(p, __ATOMIC_RELAXED, __HIP_MEMORY_SCOPE_AGENT); }
__device__ __forceinline__ unsigned xb_add(unsigned* p, unsigned v) { return __hip_atomic_fetch_add(p, v, __ATOMIC_RELAXED, __HIP_MEMORY_SCOPE_AGENT); }
__device__ __forceinline__ unsigned xb_xcc_id() { return (unsigned)__builtin_amdgcn_s_getreg((3 << 11) | 20) & 0xFu; }
#define XB_SPIN(cond, bar) do { unsigned _sp = 0; while (cond) { __builtin_amdgcn_s_sleep(1); \
    if ((++_sp & 255u) == 0u) { if (xb_ld(&(bar)[XB_TMO])) break; if (_sp > XB_SPIN_CAP) { atomicAdd(&(bar)[XB_TMO], 1u); break; } } } } while (0)
struct XcdBarrier { unsigned* bar; unsigned x; volatile LAS unsigned* st; };
__device__ __forceinline__ XcdBarrier xcd_barrier_post(unsigned* bar, volatile LAS unsigned* st) {
    XcdBarrier b; b.bar = bar; b.x = xb_xcc_id(); b.st = st;
    if (threadIdx.x == 0) (void)xb_add(&bar[XB_XCNT(b.x)], 1u);
    return b;
}
__device__ __forceinline__ void xcd_barrier_complete(unsigned* bar, unsigned x, unsigned& nloc, unsigned& nx) {
    const unsigned G = gridDim.x * gridDim.y * gridDim.z;
    unsigned sum, cnt, mine, sp = 0u;
    for (;;) {
        sum = 0u; cnt = 0u; mine = 0u;
#pragma unroll
        for (unsigned j = 0; j < 16; ++j) { const unsigned c = xb_ld(&bar[XB_XCNT(j)]); sum += c; cnt += (c > 0u) ? 1u : 0u; mine = (j == x) ? c : mine; }
        if (sum == G) break;
        __builtin_amdgcn_s_sleep(1);
        if ((++sp & 255u) == 0u) { if (xb_ld(&bar[XB_TMO])) break; if (sp > XB_SPIN_CAP) { atomicAdd(&bar[XB_TMO], 1u); break; } }
    }
    nloc = mine > 0u ? mine : 1u; nx = cnt > 0u ? cnt : 1u;
}
__device__ __forceinline__ void xcd_barrier(const XcdBarrier& b) {
    asm volatile("s_waitcnt vmcnt(0)" ::: "memory");
    __syncthreads();
    if (threadIdx.x == 0) {
        unsigned* bar = b.bar;
        __builtin_amdgcn_s_waitcnt(0);
        unsigned nloc = b.st[0], nx = b.st[1];
        if (nloc == 0u) { xcd_barrier_complete(bar, b.x, nloc, nx); b.st[0] = nloc; b.st[1] = nx; }
        const unsigned old = xb_add(&bar[XB_XSUB(b.x)], 1u);
        const unsigned gen = old / nloc;
        if (old + 1u == (gen + 1u) * nloc) {
            __builtin_amdgcn_fence(__ATOMIC_RELEASE, "agent");
            asm volatile("s_waitcnt vmcnt(0)" ::: "memory");
            const unsigned og = xb_add(&bar[XB_TOP], 1u);
            const unsigned tg = og / nx;
            if (og + 1u == (tg + 1u) * nx) xb_add(&bar[XB_TOPGEN], 1u);
            else XB_SPIN(xb_ld(&bar[XB_TOPGEN]) == tg, bar);
            __builtin_amdgcn_fence(__ATOMIC_ACQUIRE, "agent");
            xb_add(&bar[XB_XGEN(b.x)], 1u);
            asm volatile("s_waitcnt vmcnt(0)" ::: "memory");
        } else {
            XB_SPIN(xb_ld(&bar[XB_XGEN(b.x)]) == gen, bar);
            __builtin_amdgcn_fence(__ATOMIC_ACQUIRE, "agent");
            asm volatile("s_waitcnt vmcnt(0)" ::: "memory");
        }
    }
    __syncthreads();
}

constexpr int LDS_BYTES = 147456, RING_BYTES = 131072, MISC_OFF = RING_BYTES + 320;
struct Args { const float* in[16]; float* out; unsigned char* ws; int ph_lo, ph_hi; };
struct Ctx {
    const float *x_prompt, *x_sample, *cache_k, *cache_v, *c, *c_ctx, *norm_g, *w_mod, *b_mod, *w_in, *conv_w, *conv_b, *lam_vec, *subln_g, *w_out, *final_g;
    float* out; unsigned char* ws; LAS unsigned char* lds;
    int tid, lane, wave, G, bid;
};
#define WSP(T, off) ((T*)(C.ws + (off)))
__device__ __forceinline__ const float* cvec(const Ctx& C, int bb) { return bb == 0 ? C.c_ctx : C.c + (bb - 1) * DM; }

__device__ __forceinline__ void p0_transpose_item(const float* W, int ldw, int mode, u16* WT, LAS float* scr, int item, int lane) {
    const int nblk = (mode == 0 ? NMAIN : DM) / 32, kb = item / nblk, nb = item % nblk, k0 = 64 * kb, n0 = 32 * nb;
    const int srcc = mode == 0 ? orig_col(n0 + (lane & 31)) : n0 + (lane & 31);
#pragma unroll 8
    for (int i = 0; i < 32; ++i) { const int kk = 2 * i + (lane >> 5); scr[kk * 33 + (lane & 31)] = W[(size_t)(k0 + kk) * ldw + srcc]; }
    asm volatile("s_waitcnt lgkmcnt(0)" ::: "memory");
    const int c = lane & 7;
#pragma unroll
    for (int j = 0; j < 4; ++j) { const int n = (lane >> 3) + 8 * j; const LAS float* s = scr + (8 * c) * 33 + n;
        u32x4 o; o.x = pk2(s[0 * 33], s[1 * 33]); o.y = pk2(s[2 * 33], s[3 * 33]); o.z = pk2(s[4 * 33], s[5 * 33]); o.w = pk2(s[6 * 33], s[7 * 33]);
        *(u32x4*)(WT + (size_t)(n0 + n) * DM + k0 + 8 * c) = o; }
    asm volatile("s_waitcnt lgkmcnt(0)" ::: "memory");
}

__device__ __forceinline__ void phase_p0a(const Ctx& C) {
    LAS float* ldsf = (LAS float*)C.lds;
    LAS float* sil = ldsf; LAS float* T = ldsf + 5120; LAS float* red = ldsf + 6144; LAS float* scr = ldsf + 10240 + C.wave * 2112;
    for (int i = C.tid; i < 5 * DM; i += 512) { const int bb = i >> 10, k = i & 1023; sil[i] = silu(cvec(C, bb)[k]); }
    if (C.tid < 256) T[C.tid] = __builtin_amdgcn_cosf((float)C.tid * (1.f / 256.f));
    __syncthreads();
    float* MOD = WSP(float, WS_MOD);
    for (int it = C.bid; it < 96; it += C.G) {
        const int l = it / 48, n = (it % 48) * 64 + C.lane;
        const float* W = C.w_mod + (size_t)l * DM * 3072 + n;
        float a0 = 0, a1 = 0, a2 = 0, a3 = 0, a4 = 0;
        const int kb = C.wave * 128;
#pragma unroll 4
        for (int k = kb; k < kb + 128; ++k) { const float w = W[(size_t)k * 3072]; a0 += sil[k] * w; a1 += sil[1024 + k] * w; a2 += sil[2048 + k] * w; a3 += sil[3072 + k] * w; a4 += sil[4096 + k] * w; }
        LAS float* rd = red + C.wave * 320 + C.lane; rd[0] = a0; rd[64] = a1; rd[128] = a2; rd[192] = a3; rd[256] = a4;
        __syncthreads();
        if (C.tid < 320) { float s = 0; for (int w = 0; w < 8; ++w) s += red[w * 320 + C.tid]; const int bb = C.tid >> 6, nn = (it % 48) * 64 + (C.tid & 63);
            MOD[(l * 5 + bb) * 3072 + nn] = s + C.b_mod[l * 3072 + nn]; }
        __syncthreads();
    }
    const int gw = C.bid * 8 + C.wave, NGW = C.G * 8;
    constexpr int I_M = 16 * (NMAIN / 32), I_O = 16 * (DM / 32), I_F = 16 * 32;
    constexpr int I_L = I_M + I_O + I_F;
    for (int it0 = gw; it0 < 2 * I_L; it0 += NGW) {
        const int l = it0 / I_L; int it = it0 % I_L;
        if (it < I_M) { p0_transpose_item(C.w_in + (size_t)l * DM * INDIM, INDIM, 0, WSP(u16, WS_WMT) + (size_t)l * NMAIN * DM, scr, it, C.lane); continue; }
        it -= I_M;
        if (it < I_O) { p0_transpose_item(C.w_out + (size_t)l * DM * DM, DM, 1, WSP(u16, WS_WOT) + (size_t)l * DM * DM, scr, it, C.lane); continue; }
        it -= I_O;
        {
            const int ct = it >> 5, kt = it & 31, c0 = (ct & 7) * 32, k0 = kt * 32, sn = ct >> 3, s = C.lane >> 5, i = C.lane & 31;
            const float* wrow = C.w_in + (size_t)l * DM * INDIM + (size_t)(k0 + i) * INDIM + s * 128;
            const int cc = c0 + i, shift = sn ? 192 : 0;
            f32x16 acc = {};
#pragma unroll 2
            for (int t = 0; t < 128; t += 4) {
                const f32x4 b = *(const f32x4*)(wrow + t);
#pragma unroll
                for (int q = 0; q < 4; ++q) { const int j = s * 128 + t + q; const float a = T[(j * cc + shift) & 255];
                    acc = __builtin_amdgcn_mfma_f32_32x32x2f32(a, b[q], acc, 0, 0, 0); }
            }
            u16* WF = WSP(u16, WS_WFT) + (size_t)l * NFT * DM;
#pragma unroll
            for (int r = 0; r < 16; ++r) { const int row = (r & 3) + 8 * (r >> 2) + 4 * s; WF[(size_t)(sn * 256 + c0 + row) * DM + k0 + i] = (u16)f2bf(acc[r]); }
        }
    }
    const int gt = C.bid * 512 + C.tid, NT = C.G * 512;
    for (int i = gt; i < 2 * (4 * 2 * 512 * 512 / 8); i += NT) {
        const int which = i >= (4 * 2 * 512 * 512 / 8), i8 = which ? i - (4 * 2 * 512 * 512 / 8) : i;
        const int c8 = i8 & 63, key = (i8 >> 6) & 511, l = (i8 >> 15) & 1, b = i8 >> 16;
        const float* src = (which ? C.cache_v : C.cache_k) + ((size_t)((b * 2 + l) * 512 + key)) * 512 + c8 * 8;
        const f32x4 v0 = *(const f32x4*)src, v1 = *(const f32x4*)(src + 4);
        u32x4 o; o.x = pk2(v0[0], v0[1]); o.y = pk2(v0[2], v0[3]); o.z = pk2(v1[0], v1[1]); o.w = pk2(v1[2], v1[3]);
        *(u32x4*)(WSP(u16, which ? WS_CV : WS_CK) + ((size_t)((l * 4 + b) * 512 + key)) * 512 + c8 * 8) = o;
    }
    for (int i = gt; i < (2048 * 4096 + 256 * 512) / 8; i += NT) {
        const bool smp = i < 2048 * 4096 / 8; const int i8 = smp ? i : i - 2048 * 4096 / 8;
        const int N = smp ? 2048 : 256, lg = smp ? 11 : 8; const int k = i8 >> (lg - 2), n2 = (i8 & ((1 << (lg - 2)) - 1)) * 8;
        const float sc = smp ? 0.0013810679320049757f : 0.00390625f, invN = 1.f / (float)N;
        float v[8];
#pragma unroll
        for (int q = 0; q < 8; ++q) { const int nn = n2 + q, n = nn & (N - 1), sp = nn >> lg; const float fr = (float)((k * n) & (N - 1)) * invN;
            v[q] = sp ? -__builtin_amdgcn_sinf(fr) * sc : __builtin_amdgcn_cosf(fr) * sc; }
        u32x4 o; o.x = pk2(v[0], v[1]); o.y = pk2(v[2], v[3]); o.z = pk2(v[4], v[5]); o.w = pk2(v[6], v[7]);
        *(u32x4*)(WSP(u16, smp ? WS_DS : WS_DC) + (size_t)k * (2 * N) + n2) = o;
    }
    if (gt < 1024) { const int pos = gt >> 4, f = gt & 15; const float inv = powf(10000.f, -(float)f / 16.f), a = (float)pos * inv; WSP(f32x2, WS_ROPE)[gt] = (f32x2){cosf(a), sinf(a)}; }
    if (gt < 2) { const float* lv = C.lam_vec + gt * 256; float s1 = 0, s2 = 0; for (int i = 0; i < 64; ++i) { s1 += lv[i] * lv[64 + i]; s2 += lv[128 + i] * lv[192 + i]; }
        WSP(float, WS_LAM)[gt] = expf(s1) - expf(s2) + (0.8f - 0.6f * expf(-0.3f * (float)gt)); }
}

__device__ __forceinline__ void phase_p0b(const Ctx& C) {
    LAS float* ldsf = (LAS float*)C.lds;
    LAS float* sh = ldsf;
    LAS float* red = ldsf + 10240;
    const float* MOD = WSP(float, WS_MOD);
    for (int i = C.tid; i < 2 * 5 * DM; i += 512) { const int lb = i >> 10, k = i & 1023; sh[i] = MOD[lb * 3072 + k]; }
    __syncthreads();
    float* SW = WSP(float, WS_SW);
    for (int it = C.bid; it < 104; it += C.G) {
        const int l = it / 52, o = 256 + (it % 52) * 64 + C.lane;
        const float* W = C.w_in + (size_t)l * DM * INDIM + o; const LAS float* s = sh + l * 5120;
        float a0 = 0, a1 = 0, a2 = 0, a3 = 0, a4 = 0;
        const int kb = C.wave * 128;
#pragma unroll 4
        for (int k = kb; k < kb + 128; ++k) { const float w = W[(size_t)k * INDIM]; a0 += s[k] * w; a1 += s[1024 + k] * w; a2 += s[2048 + k] * w; a3 += s[3072 + k] * w; a4 += s[4096 + k] * w; }
        LAS float* rd = red + C.wave * 320 + C.lane; rd[0] = a0; rd[64] = a1; rd[128] = a2; rd[192] = a3; rd[256] = a4;
        __syncthreads();
        if (C.tid < 320) { float sm = 0; for (int w = 0; w < 8; ++w) sm += red[w * 320 + C.tid]; const int bb = C.tid >> 6, oo = 256 + (it % 52) * 64 + (C.tid & 63);
            SW[(l * 5 + bb) * NMAIN + tile_col(oo)] = sm; }
        __syncthreads();
    }
    const int gw = C.bid * 8 + C.wave, NGW = C.G * 8;
    float* SWF = WSP(float, WS_SWF);
    for (int it = gw; it < 2 * NFT; it += NGW) {
        const int l = it >> 9, cc = it & 511; const u16* wr = WSP(u16, WS_WFT) + ((size_t)l * NFT + cc) * DM + C.lane * 16;
        const u32x4 w0 = *(const u32x4*)wr, w1 = *(const u32x4*)(wr + 8); const LAS float* s = sh + l * 5120 + C.lane * 16;
        float wv[16] = {bflo(w0.x), bfhi(w0.x), bflo(w0.y), bfhi(w0.y), bflo(w0.z), bfhi(w0.z), bflo(w0.w), bfhi(w0.w), bflo(w1.x), bfhi(w1.x), bflo(w1.y), bfhi(w1.y), bflo(w1.z), bfhi(w1.z), bflo(w1.w), bfhi(w1.w)};
#pragma unroll
        for (int bb = 0; bb < 5; ++bb) { float a = 0;
#pragma unroll
            for (int q = 0; q < 16; ++q) a += wv[q] * s[bb * 1024 + q];
            a = wave_sum(a); if (C.lane == 0) SWF[(l * 5 + bb) * NFT + cc] = a; }
    }
    u16* AP = WSP(u16, WS_AP); float* PART = WSP(float, WS_PART);
    for (int r = gw; r < NTOK; r += NGW) {
        const float* xr = (r < NCTX ? C.x_prompt + (size_t)r * DM : C.x_sample + (size_t)(r - NCTX) * DM); const int bb = modid(r);
        float ss = 0;
#pragma unroll
        for (int j = 0; j < 4; ++j) { const int k = 256 * j + 4 * C.lane; const f32x4 v = *(const f32x4*)(xr + k), g = *(const f32x4*)(C.norm_g + k), sc = *(const f32x4*)(MOD + bb * 3072 + 1024 + k);
            ss += (v[0] * v[0] + v[1] * v[1]) + (v[2] * v[2] + v[3] * v[3]);
            u32x2 o; o.x = pk2(v[0] * g[0] * (1.f + sc[0]), v[1] * g[1] * (1.f + sc[1])); o.y = pk2(v[2] * g[2] * (1.f + sc[2]), v[3] * g[3] * (1.f + sc[3]));
            *(u32x2*)(AP + (size_t)r * DM + k) = o; }
        ss = wave_sum(ss);
        if (C.lane < 16) PART[(size_t)r * 16 + C.lane] = C.lane == 0 ? ss : 0.f;
    }
}
__device__ __forceinline__ float dotbf(const u16* a, const u16* b, int K) {
    float s0 = 0, s1 = 0, s2 = 0, s3 = 0;
    for (int k = 0; k < K; k += 8) {
        const u32x4 x = *(const u32x4*)(a + k), y = *(const u32x4*)(b + k);
        s0 += bflo(x.x) * bflo(y.x) + bfhi(x.x) * bfhi(y.x); s1 += bflo(x.y) * bflo(y.y) + bfhi(x.y) * bfhi(y.y);
        s2 += bflo(x.z) * bflo(y.z) + bfhi(x.z) * bfhi(y.z); s3 += bflo(x.w) * bflo(y.w) + bfhi(x.w) * bfhi(y.w);
    }
    return (s0 + s1) + (s2 + s3);
}
__device__ __forceinline__ float row_rstd(const float* PART, int r) {
    const f32x4* p = (const f32x4*)(PART + (size_t)r * 16); const f32x4 a = p[0], b = p[1], c = p[2], d = p[3];
    const float s = ((a[0] + a[1]) + (a[2] + a[3])) + ((b[0] + b[1]) + (b[2] + b[3])) + ((c[0] + c[1]) + (c[2] + c[3])) + ((d[0] + d[1]) + (d[2] + d[3]));
    return 1.f / sqrtf(s * (1.f / 1024.f) + EPS);
}
__device__ __forceinline__ size_t newkv_off(int r, int l, int c) { const int b = r >> 8, t = r & 255; return ((size_t)((b * 2 + l) * 256 + t)) * 512 + c; }

__device__ __forceinline__ void naive_p1(const Ctx& C, int l) {
    const u16* AP = WSP(u16, WS_AP); const u16* WM = WSP(u16, WS_WMT) + (size_t)l * NMAIN * DM; const u16* WF = WSP(u16, WS_WFT) + (size_t)l * NFT * DM;
    const float* PART = WSP(float, WS_PART); const float* SW = WSP(float, WS_SW) + l * 5 * NMAIN; const float* SWF = WSP(float, WS_SWF) + l * 5 * NFT;
    const f32x2* ROPE = WSP(f32x2, WS_ROPE);
    u16 *SGA = WSP(u16, WS_SGA), *U = WSP(u16, WS_U), *WC = WSP(u16, WS_WC), *Q = WSP(u16, WS_Q), *K = WSP(u16, WS_K), *V = WSP(u16, WS_V), *SGC = WSP(u16, WS_SGC);
    const long gt = (long)C.bid * 512 + C.tid, NT = (long)C.G * 512;
    for (long idx = gt; idx < (long)NTOK * 3072; idx += NT) {
        const int r = (int)(idx / 3072), o = (int)(idx % 3072), bb = modid(r); const float rs = row_rstd(PART, r); const u16* a = AP + (size_t)r * DM;
#define ZM(j) (rs * dotbf(a, WM + (size_t)(j) * DM, DM) + SW[bb * NMAIN + (j)])
        if (o < 256) { SGA[(size_t)r * 256 + o] = (u16)f2bf(silu(ZM(inv_o8(o)))); }
        else if (o < 512) { const int ch = o - 256, t = ch >> 6, c6 = ch & 63, wc = c6 >> 4, fq = (c6 >> 2) & 3, e = c6 & 3; const int jb = 256 * (1 + t) + 32 * wc + 4 * fq + e;
            const float bg = ZM(jb), cg = ZM(jb + 16), hc = ZM(jb + 128), gb = ZM(jb + 144);
            U[(size_t)r * 256 + ch] = (u16)f2bf(cg * hc); WC[(size_t)r * 256 + ch] = (u16)f2bf(bg * silu(gb)); }
        else if (o < 1536) { const bool isk = o >= 1024; const int c = isk ? o - 1024 : o - 512; const int jb = isk ? 1792 : 1280; float z = ZM(jb + c);
            if (r >= NCTX) { const float zp = ZM(jb + (c ^ 16)); const int t = (r - NCTX) & 2047, w = c & 63, axis = w >> 5, i = w & 31, pos = axis ? (t & 63) : (t >> 6); const f32x2 cs = ROPE[pos * 16 + (i & 15)];
                z = (i < 16) ? z * cs.x - zp * cs.y : z * cs.x + zp * cs.y; }
            else if (isk) C.out[OUT_NK + newkv_off(r, l, c)] = z;
            if (isk) K[(size_t)r * 512 + c] = (u16)f2bf(z); else Q[(size_t)r * 512 + c] = (u16)f2bf(z * QSCALE); }
        else if (o < 2048) { const int c = o - 1536; const float z = ZM(2304 + (c >> 8) * 256 + inv_o8(c & 255)); V[(size_t)r * 512 + c] = (u16)f2bf(z); if (r < NCTX) C.out[OUT_NV + newkv_off(r, l, c)] = z; }
        else if (o < 2560) { const int c = o - 2048; SGC[(size_t)r * 512 + c] = (u16)f2bf(silu(ZM(2816 + (c >> 8) * 256 + inv_o8(c & 255)))); }
        else { const int cc = o - 2560, ch = cc & 255, sp = cc >> 8; const float z = rs * dotbf(a, WF + (size_t)cc * DM, DM) + SWF[bb * NFT + cc];
            if (r < NCTX) { const int b = r >> 8, n = r & 255; WSP(u16, WS_XTC)[((size_t)(b * 256 + ch)) * 512 + sp * 256 + n] = (u16)f2bf(z); }
            else { const int b = (r - NCTX) >> 11, n = (r - NCTX) & 2047; WSP(u16, WS_XTS)[((size_t)(b * 256 + ch)) * 4096 + sp * 2048 + n] = (u16)f2bf(z); } }
#undef ZM
    }
}

__device__ __forceinline__ void naive_fourier(const Ctx& C) {
    const long gt = (long)C.bid * 512 + C.tid, NT = (long)C.G * 512; const u16* SGA = WSP(u16, WS_SGA); u16* Y = WSP(u16, WS_YMIX);
    for (long idx = gt; idx < (long)NTOK * 256; idx += NT) {
        const int r = (int)(idx >> 8), c = (int)(idx & 255); float y;
        if (r < NCTX) { const int b = r >> 8, k = r & 255; y = dotbf(WSP(u16, WS_DC) + (size_t)k * 512, WSP(u16, WS_XTC) + ((size_t)(b * 256 + c)) * 512, 512); }
        else { const int b = (r - NCTX) >> 11, k = (r - NCTX) & 2047; y = dotbf(WSP(u16, WS_DS) + (size_t)k * 4096, WSP(u16, WS_XTS) + ((size_t)(b * 256 + c)) * 4096, 4096); }
        Y[(size_t)r * DM + c] = (u16)f2bf(y * bf2f(SGA[(size_t)r * 256 + c]));
    }
}
__device__ __forceinline__ void conv_items(const Ctx& C, int l, long first, long step) {
    const u16* U = WSP(u16, WS_U); const u16* WCb = WSP(u16, WS_WC); u16* Y = WSP(u16, WS_YMIX); const float* cw = C.conv_w + l * 768; const float* cb = C.conv_b + l * 256;
    for (long idx = first; idx < (long)NTOK * 32; idx += step) {
        const int r = (int)(idx >> 5), c0 = (int)(idx & 31) * 8; const int t = r < NCTX ? (r & 255) : ((r - NCTX) & 2047), L = r < NCTX ? 256 : 2048;
        const u32x4 z = {0u, 0u, 0u, 0u};
        const u32x4 um = t > 0 ? *(const u32x4*)(U + (size_t)(r - 1) * 256 + c0) : z, u0 = *(const u32x4*)(U + (size_t)r * 256 + c0), up = t < L - 1 ? *(const u32x4*)(U + (size_t)(r + 1) * 256 + c0) : z;
        const u32x4 wv = *(const u32x4*)(WCb + (size_t)r * 256 + c0);
        unsigned o[4];
#pragma unroll
        for (int q = 0; q < 4; ++q) { const int ca = c0 + 2 * q, cb2 = ca + 1;
            const float ya = bflo(um[q]) * cw[ca] + bflo(u0[q]) * cw[256 + ca] + bflo(up[q]) * cw[512 + ca] + cb[ca];
            const float yb = bfhi(um[q]) * cw[cb2] + bfhi(u0[q]) * cw[256 + cb2] + bfhi(up[q]) * cw[512 + cb2] + cb[cb2];
            o[q] = pk2(ya * bflo(wv[q]), yb * bfhi(wv[q])); }
        *(u32x4*)(Y + (size_t)r * DM + 256 + c0) = (u32x4){o[0], o[1], o[2], o[3]};
    }
}
__device__ __forceinline__ void naive_attn(const Ctx& C, int l) {
    const int gw = C.bid * 8 + C.wave, NGW = C.G * 8, lane = C.lane;
    const u16 *Q = WSP(u16, WS_Q), *K = WSP(u16, WS_K), *V = WSP(u16, WS_V), *SGC = WSP(u16, WS_SGC); u16* Y = WSP(u16, WS_YMIX);
    const float lam = WSP(float, WS_LAM)[l], lam_init = 0.8f - 0.6f * expf(-0.3f * (float)l);
    for (int task = gw; task < NTOK * 4; task += NGW) {
        const int r = task >> 2, h = task & 3; const u16* q = Q + (size_t)r * 512 + h * 128;
        int M, nc; const u16 *k0p, *v0p, *k1p, *v1p;
        if (r < NCTX) { const int b = r >> 8; M = 256; nc = 0; k0p = v0p = nullptr; k1p = K + (size_t)(b * 256) * 512 + h * 128; v1p = V + (size_t)(b * 256) * 512 + h * 128; }
        else { const int b = (r - NCTX) >> 11; M = 2560; nc = 512; k0p = WSP(u16, WS_CK) + ((size_t)((l * 4 + b) * 512)) * 512 + h * 128; v0p = WSP(u16, WS_CV) + ((size_t)((l * 4 + b) * 512)) * 512 + h * 128;
            k1p = K + (size_t)(NCTX + b * 2048) * 512 + h * 128; v1p = V + (size_t)(NCTX + b * 2048) * 512 + h * 128; }
        float m1 = -1e30f, m2 = -1e30f;
        for (int kk = 0; kk < M; kk += 64) { const int key = kk + lane; const u16* kp = key < nc ? k0p + (size_t)key * 512 : k1p + (size_t)(key - nc) * 512;
            m1 = fmaxf(m1, dotbf(q, kp, 64)); m2 = fmaxf(m2, dotbf(q + 64, kp + 64, 64)); }
        m1 = wave_max(m1); m2 = wave_max(m2);
        float l1 = 0, l2 = 0, o1a = 0, o1b = 0, o2a = 0, o2b = 0;
        for (int kk = 0; kk < M; kk += 64) { const int key = kk + lane; const u16* kp = key < nc ? k0p + (size_t)key * 512 : k1p + (size_t)(key - nc) * 512;
            const float p1 = exp2f(dotbf(q, kp, 64) - m1), p2 = exp2f(dotbf(q + 64, kp + 64, 64) - m2); l1 += p1; l2 += p2;
            const u16* vb = kk < nc ? v0p + (size_t)kk * 512 : v1p + (size_t)(kk - nc) * 512;
            for (int j = 0; j < 64; ++j) { const float a = __shfl(p1, j), b = __shfl(p2, j); const unsigned vv = *(const unsigned*)(vb + (size_t)j * 512 + 2 * lane);
                o1a += a * bflo(vv); o1b += a * bfhi(vv); o2a += b * bflo(vv); o2b += b * bfhi(vv); } }
        l1 = wave_sum(l1); l2 = wave_sum(l2);
        float oa = o1a / l1 - lam * (o2a / l2), ob = o1b / l1 - lam * (o2b / l2);
        const float ss = wave_sum(oa * oa + ob * ob), rs = (1.f - lam_init) / sqrtf(ss * (1.f / 128.f) + EPS);
        const float* g = C.subln_g + l * 128 + 2 * lane; const unsigned gc = *(const unsigned*)(SGC + (size_t)r * 512 + h * 128 + 2 * lane);
        *(unsigned*)(Y + (size_t)r * DM + 512 + h * 128 + 2 * lane) = pk2(oa * rs * g[0] * bflo(gc), ob * rs * g[1] * bfhi(gc));
    }
}
__device__ __forceinline__ void naive_p3(const Ctx& C, int l) {
    const int gw = C.bid * 8 + C.wave, NGW = C.G * 8, lane = C.lane;
    const u16* Y = WSP(u16, WS_YMIX); const u16* WO = WSP(u16, WS_WOT) + (size_t)l * DM * DM; const float* MOD = WSP(float, WS_MOD);
    float* X1 = WSP(float, WS_X1); u16* AP = WSP(u16, WS_AP); float* PART = WSP(float, WS_PART);
    for (int r = gw; r < NTOK; r += NGW) {
        const int bb = modid(r); const float* gate = MOD + (l * 5 + bb) * 3072 + 2048;
        const float* xold = l == 0 ? (r < NCTX ? C.x_prompt + (size_t)r * DM : C.x_sample + (size_t)(r - NCTX) * DM) : X1 + (size_t)r * DM;
        float* xnew = l == 0 ? X1 + (size_t)r * DM : C.out + (size_t)r * DM;
        float ss = 0;
#pragma unroll 1
        for (int j = 0; j < 16; ++j) { const int c = 64 * j + lane; const float acc = dotbf(Y + (size_t)r * DM, WO + (size_t)c * DM, DM); const float v = xold[c] + gate[c] * acc; xnew[c] = v; ss += v * v; }
        ss = wave_sum(ss);
        if (l == 0) {
            const float* sc = MOD + (5 + bb) * 3072 + 1024;
#pragma unroll 1
            for (int j = 0; j < 16; ++j) { const int c = 64 * j + lane; AP[(size_t)r * DM + c] = (u16)f2bf(xnew[c] * C.norm_g[DM + c] * (1.f + sc[c])); }
            if (lane < 16) PART[(size_t)r * 16 + lane] = lane == 0 ? ss : 0.f;
        } else {
            const float rs = 1.f / sqrtf(ss * (1.f / 1024.f) + EPS);
#pragma unroll 1
            for (int j = 0; j < 16; ++j) { const int c = 64 * j + lane; xnew[c] = xnew[c] * rs * C.final_g[c]; }
        }
    }
}
__global__ void __launch_bounds__(512, 2) mk_fwd(Args a) {
    extern __shared__ __attribute__((aligned(16))) unsigned char lds[];
    Ctx C;
    C.x_prompt = a.in[0]; C.x_sample = a.in[1]; C.cache_k = a.in[2]; C.cache_v = a.in[3]; C.c = a.in[4]; C.c_ctx = a.in[5]; C.norm_g = a.in[6]; C.w_mod = a.in[7];
    C.b_mod = a.in[8]; C.w_in = a.in[9]; C.conv_w = a.in[10]; C.conv_b = a.in[11]; C.lam_vec = a.in[12]; C.subln_g = a.in[13]; C.w_out = a.in[14]; C.final_g = a.in[15];
    C.out = a.out; C.ws = a.ws; C.lds = (LAS unsigned char*)lds;
    C.tid = threadIdx.x; C.lane = C.tid & 63; C.wave = __builtin_amdgcn_readfirstlane(C.tid >> 6); C.G = gridDim.x; C.bid = blockIdx.x;
    volatile LAS unsigned* MISC = (volatile LAS unsigned*)(C.lds + MISC_OFF);
    if (C.tid < 32) MISC[C.tid] = 0u;
    __syncthreads();
    XcdBarrier bar = xcd_barrier_post(WSP(unsigned, WS_CTL) + CW_BAR, MISC + 8);
#define GRID_BAR() xcd_barrier(bar)
    phase_p0a(C); GRID_BAR();
    phase_p0b(C); GRID_BAR();
    for (int l = 0; l < 2; ++l) {
        naive_p1(C, l); GRID_BAR();
        naive_fourier(C); conv_items(C, l, (long)C.bid * 512 + C.tid, (long)C.G * 512); naive_attn(C, l); GRID_BAR();
        naive_p3(C, l); if (l == 0) GRID_BAR();
    }
}

extern "C" void kernel_launch(void* const* d_in, const int* in_sizes, int n_in, void* d_out, int out_size, void* d_ws, size_t ws_size, hipStream_t stream) {
    static int grid = 0;
    if (grid == 0) {
        if (n_in != 16 || out_size != (int)OUT_TOTAL || ws_size < WS_END) { fprintf(stderr, "kernel_launch: unexpected shapes (n_in %d out %d ws %zu)\n", n_in, out_size, ws_size); grid = -1; return; }
        int dev = 0, cus = 0, per_cu = 0;
        if (hipGetDevice(&dev) != hipSuccess || hipDeviceGetAttribute(&cus, hipDeviceAttributeMultiprocessorCount, dev) != hipSuccess) { grid = -1; return; }
        if (hipFuncSetAttribute((const void*)mk_fwd, hipFuncAttributeMaxDynamicSharedMemorySize, LDS_BYTES) != hipSuccess) { fprintf(stderr, "kernel_launch: hipFuncSetAttribute failed\n"); grid = -1; return; }
        if (hipOccupancyMaxActiveBlocksPerMultiprocessor(&per_cu, (const void*)mk_fwd, 512, LDS_BYTES) != hipSuccess || per_cu < 1) { fprintf(stderr, "kernel_launch: occupancy query says %d blocks/CU\n", per_cu); (void)hipGetLastError(); grid = -1; return; }
        grid = cus;
    }
    if (grid < 0) return;
    if (hipMemsetAsync((char*)d_ws + WS_CTL, 0, 1u << 20, stream) != hipSuccess) return;
    Args a{};
    for (int i = 0; i < 16; ++i) a.in[i] = (const float*)d_in[i];
    a.out = (float*)d_out; a.ws = (unsigned char*)d_ws; a.ph_lo = 0; a.ph_hi = 99;
    hipLaunchKernelGGL(mk_fwd, dim3(grid), dim3(512), LDS_BYTES, stream, a);
}
```

```cpp
#include <hip/hip_runtime.h>
#include <cstdio>
#include <cstdint>
#define LAS __attribute__((address_space(3)))
typedef unsigned short u16;
typedef unsigned u32x4 __attribute__((ext_vector_type(4)));
typedef unsigned u32x2 __attribute__((ext_vector_type(2)));
typedef float f32x4 __attribute__((ext_vector_type(4)));
typedef float f32x2 __attribute__((ext_vector_type(2)));
typedef float f32x16 __attribute__((ext_vector_type(16)));
typedef short bf16x8 __attribute__((ext_vector_type(8)));
typedef short s16x4 __attribute__((ext_vector_type(4)));

constexpr int DM = 1024, NCTX = 4096, NSMP = 8192, NTOK = 12288, CTX_SEQ = 256, SMP_SEQ = 2048, PAST = 512;
constexpr int INDIM = 3584, NMAIN = 3328, NFT = 512;
constexpr float EPS = 1e-6f;
constexpr float QSCALE = 0.125f * 1.4426950408889634f;
constexpr size_t OUT_YP = 0, OUT_YS = 4194304, OUT_NK = 12582912, OUT_NV = 16777216, OUT_TOTAL = 20971520;

constexpr size_t MiB = 1u << 20;
constexpr size_t WS_CTL = 0;
constexpr size_t WS_WMT = 1 * MiB;
constexpr size_t WS_WFT = 14 * MiB;
constexpr size_t WS_WOT = 16 * MiB;
constexpr size_t WS_CK = 20 * MiB;
constexpr size_t WS_CV = 24 * MiB;
constexpr size_t WS_DS = 28 * MiB;
constexpr size_t WS_DC = 44 * MiB;
constexpr size_t WS_MOD = 44 * MiB + 512 * 1024;
constexpr size_t WS_SW = 44 * MiB + 768 * 1024;
constexpr size_t WS_SWF = 45 * MiB;
constexpr size_t WS_ROPE = 45 * MiB + 64 * 1024;
constexpr size_t WS_LAM = 45 * MiB + 128 * 1024;
constexpr size_t WS_PART = 46 * MiB;
constexpr size_t WS_AP = 47 * MiB;
constexpr size_t WS_XTS = 71 * MiB;
constexpr size_t WS_XTC = 79 * MiB;
constexpr size_t WS_SGA = 83 * MiB;
constexpr size_t WS_U = 89 * MiB;
constexpr size_t WS_WC = 95 * MiB;
constexpr size_t WS_Q = 101 * MiB;
constexpr size_t WS_K = 113 * MiB;
constexpr size_t WS_V = 125 * MiB;
constexpr size_t WS_SGC = 137 * MiB;
constexpr size_t WS_YMIX = 149 * MiB;
constexpr size_t WS_X1 = 173 * MiB;
constexpr size_t WS_END = 221 * MiB;
constexpr int CW_BAR = 4096;
constexpr int CW_QUEUE = 8192;

__device__ __forceinline__ unsigned f2bf(float f) { unsigned u = __builtin_bit_cast(unsigned, f); return (u + 0x7fffu + ((u >> 16) & 1u)) >> 16; }
__device__ __forceinline__ unsigned pk2(float lo, float hi) { return f2bf(lo) | (f2bf(hi) << 16); }
__device__ __forceinline__ float bflo(unsigned u) { return __builtin_bit_cast(float, u << 16); }
__device__ __forceinline__ float bfhi(unsigned u) { return __builtin_bit_cast(float, u & 0xffff0000u); }
__device__ __forceinline__ float bf2f(u16 h) { return __builtin_bit_cast(float, (unsigned)h << 16); }
__device__ __forceinline__ float silu(float x) { return x / (1.f + __expf(-x)); }
__device__ __forceinline__ float wave_sum(float v) {
#pragma unroll
    for (int o = 1; o < 64; o <<= 1) v += __shfl_xor(v, o);
    return v;
}
__device__ __forceinline__ float wave_max(float v) {
#pragma unroll
    for (int o = 1; o < 64; o <<= 1) v = fmaxf(v, __shfl_xor(v, o));
    return v;
}
__device__ __forceinline__ int modid(int r) { return r < NCTX ? 0 : 1 + ((r - NCTX) >> 11); }
__device__ __forceinline__ int o8(int jj) { const int bj = jj >> 7, wc = (jj >> 5) & 3, n = (jj >> 4) & 1, fq = (jj >> 2) & 3, e = jj & 3; return 128 * bj + 32 * wc + 8 * fq + 4 * n + e; }
__device__ __forceinline__ int inv_o8(int o) { const int bj = o >> 7, wc = (o >> 5) & 3, fq = (o >> 3) & 3, n = (o >> 2) & 1, e = o & 3; return 128 * bj + 32 * wc + 16 * n + 4 * fq + e; }
__device__ __forceinline__ int orig_col(int j) {
    const int T = j >> 8, jj = j & 255;
    if (T == 0) return 256 + o8(jj);
    if (T <= 4) { const int bj = jj >> 7, wc = (jj >> 5) & 3, n = (jj >> 4) & 1, fq = (jj >> 2) & 3, e = jj & 3; return 512 + 256 * (bj * 2 + n) + (T - 1) * 64 + 16 * wc + 4 * fq + e; }
    if (T <= 6) return 1536 + (T - 5) * 256 + jj;
    if (T <= 8) return 2048 + (T - 7) * 256 + jj;
    if (T <= 10) return 2560 + (T - 9) * 256 + o8(jj);
    return 3072 + (T - 11) * 256 + o8(jj);
}
__device__ __forceinline__ int tile_col(int o) {
    if (o < 512) return inv_o8(o - 256);
    if (o < 1536) { const int grp = (o - 512) >> 8, ch = (o - 512) & 255, t = ch >> 6, c6 = ch & 63, wc = c6 >> 4, fq = (c6 >> 2) & 3, e = c6 & 3; return 256 * (1 + t) + 128 * (grp >> 1) + 32 * wc + 16 * (grp & 1) + 4 * fq + e; }
    if (o < 2048) return 1280 + (o - 1536);
    if (o < 2560) return 1792 + (o - 2048);
    if (o < 3072) { const int c = o - 2560; return 2304 + (c >> 8) * 256 + inv_o8(c & 255); }
    { const int c = o - 3072; return 2816 + (c >> 8) * 256 + inv_o8(c & 255); }
}

#define XB_TMO      128
#define XB_XCNT(j)  (256  + 64 * (j))
#define XB_XSUB(j)  (1280 + 64 * (j))
#define XB_XGEN(j)  (2304 + 64 * (j))
#define XB_TOP      3328
#define XB_TOPGEN   3392
#define XCD_BAR_WORDS 3456
#define XB_SPIN_CAP (1u << 18)
__device__ __forceinline__ unsigned xb_ld(unsigned* p)              { return __hip_atomic_load(p, __ATOMIC_RELAXED, __HIP_MEMORY_SCOPE_AGENT); }
__device__ __forceinline__ unsigned xb_add(unsigned* p, unsigned v) { return __hip_atomic_fetch_add(p, v, __ATOMIC_RELAXED, __HIP_MEMORY_SCOPE_AGENT); }
__device__ __forceinline__ unsigned xb_xcc_id() { return (unsigned)__builtin_amdgcn_s_getreg((3 << 11) | 20) & 0xFu; }
#define XB_SPIN(cond, bar) do { unsigned _sp = 0; while (cond) { __builtin_amdgcn_s_sleep(1); \
    if ((++_sp & 255u) == 0u) { if (xb_ld(&(bar)[XB_TMO])) break; if (_sp > XB_SPIN_CAP) { atomicAdd(&(bar)[XB_TMO], 1u); break; } } } } while (0)
struct XcdBarrier { unsigned* bar; unsigned x; volatile LAS unsigned* st; };
__device__ __forceinline__ XcdBarrier xcd_barrier_post(unsigned* bar, volatile LAS unsigned* st) {
    XcdBarrier b; b.bar = bar; b.x = xb_xcc_id(); b.st = st;
    if (threadIdx.x == 0) (void)xb_add(&bar[XB_XCNT(b.x)], 1u);
    return b;
}
__device__ __forceinline__ void xcd_barrier_complete(unsigned* bar, unsigned x, unsigned& nloc, unsigned& nx) {
    const unsigned G = gridDim.x * gridDim.y * gridDim.z;
    unsigned sum, cnt, mine, sp = 0u;
    for (;;) {
        sum = 0u; cnt = 0u; mine = 0u;
#pragma unroll
        for (unsigned j = 0; j < 16; ++j) { const unsigned c = xb_ld(&bar[XB_XCNT(j)]); sum += c; cnt += (c > 0u) ? 1u : 0u; mine = (j == x) ? c : mine; }
        if (sum == G) break;
        __builtin_amdgcn_s_sleep(1);
        if ((++sp & 255u) == 0u) { if (xb_ld(&bar[XB_TMO])) break; if (sp > XB_SPIN_CAP) { atomicAdd(&bar[XB_TMO], 1u); break; } }
    }
    nloc = mine > 0u ? mine : 1u; nx = cnt > 0u ? cnt : 1u;
}
__device__ __forceinline__ void xcd_barrier(const XcdBarrier& b) {
    asm volatile("s_waitcnt vmcnt(0)" ::: "memory");
    __syncthreads();
    unsigned bx = __builtin_amdgcn_readfirstlane(b.x); asm volatile("" : "+s"(bx));
    if (threadIdx.x == 0) {
        unsigned* bar = b.bar;
        __builtin_amdgcn_s_waitcnt(0);
        unsigned nloc = b.st[0], nx = b.st[1];
        if (nloc == 0u) { xcd_barrier_complete(bar, bx, nloc, nx); b.st[0] = nloc; b.st[1] = nx; }
        const unsigned old = xb_add(&bar[XB_XSUB(bx)], 1u);
        const unsigned gen = old / nloc;
        if (old + 1u == (gen + 1u) * nloc) {
            __builtin_amdgcn_fence(__ATOMIC_RELEASE, "agent");
            asm volatile("s_waitcnt vmcnt(0)" ::: "memory");
            const unsigned og = xb_add(&bar[XB_TOP], 1u);
            const unsigned tg = og / nx;
            if (og + 1u == (tg + 1u) * nx) xb_add(&bar[XB_TOPGEN], 1u);
            else XB_SPIN(xb_ld(&bar[XB_TOPGEN]) == tg, bar);
            __builtin_amdgcn_fence(__ATOMIC_ACQUIRE, "agent");
            xb_add(&bar[XB_XGEN(bx)], 1u);
            asm volatile("s_waitcnt vmcnt(0)" ::: "memory");
        } else {
            XB_SPIN(xb_ld(&bar[XB_XGEN(bx)]) == gen, bar);
            __builtin_amdgcn_fence(__ATOMIC_ACQUIRE, "agent");
            asm volatile("s_waitcnt vmcnt(0)" ::: "memory");
        }
    }
    __syncthreads();
}

constexpr int LDS_BYTES = 147456, RING_BYTES = 131072, MISC_OFF = RING_BYTES + 320, RSTD_OFF = RING_BYTES + 1024;
struct Args { const float* in[16]; float* out; unsigned char* ws; int ph_lo, ph_hi; };
struct Ctx {
    const float *x_prompt, *x_sample, *cache_k, *cache_v, *c, *c_ctx, *norm_g, *w_mod, *b_mod, *w_in, *conv_w, *conv_b, *lam_vec, *subln_g, *w_out, *final_g;
    float* out; unsigned char* ws; LAS unsigned char* lds;
    int tid, lane, wave, G, bid;
};
#define WSP(T, off) ((T*)(C.ws + (off)))
__device__ __forceinline__ const float* cvec(const Ctx& C, int bb) { return bb == 0 ? C.c_ctx : C.c + (bb - 1) * DM; }

__device__ __forceinline__ void p0_transpose_item(const float* W, int ldw, int mode, u16* WT, LAS float* scr, int item, int lane) {
    const int nblk = (mode == 0 ? NMAIN : DM) / 32, kb = item / nblk, nb = item % nblk, k0 = 64 * kb, n0 = 32 * nb;
    const int srcc = mode == 0 ? orig_col(n0 + (lane & 31)) : n0 + (lane & 31);
#pragma unroll 8
    for (int i = 0; i < 32; ++i) { const int kk = 2 * i + (lane >> 5); scr[kk * 33 + (lane & 31)] = W[(size_t)(k0 + kk) * ldw + srcc]; }
    asm volatile("s_waitcnt lgkmcnt(0)" ::: "memory");
    const int c = lane & 7;
#pragma unroll
    for (int j = 0; j < 4; ++j) { const int n = (lane >> 3) + 8 * j; const LAS float* s = scr + (8 * c) * 33 + n;
        u32x4 o; o.x = pk2(s[0 * 33], s[1 * 33]); o.y = pk2(s[2 * 33], s[3 * 33]); o.z = pk2(s[4 * 33], s[5 * 33]); o.w = pk2(s[6 * 33], s[7 * 33]);
        *(u32x4*)(WT + (size_t)(n0 + n) * DM + k0 + 8 * c) = o; }
    asm volatile("s_waitcnt lgkmcnt(0)" ::: "memory");
}

__device__ __forceinline__ void phase_p0a(const Ctx& C) {
    LAS float* ldsf = (LAS float*)C.lds;
    LAS float* sil = ldsf; LAS float* T = ldsf + 5120; LAS float* red = ldsf + 6144; LAS float* scr = ldsf + 10240 + C.wave * 2112;
    for (int i = C.tid; i < 5 * DM; i += 512) { const int bb = i >> 10, k = i & 1023; sil[i] = silu(cvec(C, bb)[k]); }
    if (C.tid < 256) T[C.tid] = __builtin_amdgcn_cosf((float)C.tid * (1.f / 256.f));
    __syncthreads();
    float* MOD = WSP(float, WS_MOD);
    for (int it = C.bid; it < 96; it += C.G) {
        const int l = it / 48, n = (it % 48) * 64 + C.lane;
        const float* W = C.w_mod + (size_t)l * DM * 3072 + n;
        float a0 = 0, a1 = 0, a2 = 0, a3 = 0, a4 = 0;
        const int kb = C.wave * 128;
#pragma unroll 4
        for (int k = kb; k < kb + 128; ++k) { const float w = W[(size_t)k * 3072]; a0 += sil[k] * w; a1 += sil[1024 + k] * w; a2 += sil[2048 + k] * w; a3 += sil[3072 + k] * w; a4 += sil[4096 + k] * w; }
        LAS float* rd = red + C.wave * 320 + C.lane; rd[0] = a0; rd[64] = a1; rd[128] = a2; rd[192] = a3; rd[256] = a4;
        __syncthreads();
        if (C.tid < 320) { float s = 0; for (int w = 0; w < 8; ++w) s += red[w * 320 + C.tid]; const int bb = C.tid >> 6, nn = (it % 48) * 64 + (C.tid & 63);
            MOD[(l * 5 + bb) * 3072 + nn] = s + C.b_mod[l * 3072 + nn]; }
        __syncthreads();
    }
    const int gw = C.bid * 8 + C.wave, NGW = C.G * 8;
    constexpr int I_M = 16 * (NMAIN / 32), I_O = 16 * (DM / 32), I_F = 16 * 32;
    constexpr int I_L = I_M + I_O + I_F;
    for (int it0 = gw; it0 < 2 * I_L; it0 += NGW) {
        const int l = it0 / I_L; int it = it0 % I_L;
        if (it < I_M) { p0_transpose_item(C.w_in + (size_t)l * DM * INDIM, INDIM, 0, WSP(u16, WS_WMT) + (size_t)l * NMAIN * DM, scr, it, C.lane); continue; }
        it -= I_M;
        if (it < I_O) { p0_transpose_item(C.w_out + (size_t)l * DM * DM, DM, 1, WSP(u16, WS_WOT) + (size_t)l * DM * DM, scr, it, C.lane); continue; }
        it -= I_O;
        {
            const int ct = it >> 5, kt = it & 31, c0 = (ct & 7) * 32, k0 = kt * 32, sn = ct >> 3, s = C.lane >> 5, i = C.lane & 31;
            const float* wrow = C.w_in + (size_t)l * DM * INDIM + (size_t)(k0 + i) * INDIM + s * 128;
            const int cc = c0 + i, shift = sn ? 192 : 0;
            f32x16 acc = {};
#pragma unroll 2
            for (int t = 0; t < 128; t += 4) {
                const f32x4 b = *(const f32x4*)(wrow + t);
#pragma unroll
                for (int q = 0; q < 4; ++q) { const int j = s * 128 + t + q; const float a = T[(j * cc + shift) & 255];
                    acc = __builtin_amdgcn_mfma_f32_32x32x2f32(a, b[q], acc, 0, 0, 0); }
            }
            u16* WF = WSP(u16, WS_WFT) + (size_t)l * NFT * DM;
#pragma unroll
            for (int r = 0; r < 16; ++r) { const int row = (r & 3) + 8 * (r >> 2) + 4 * s; WF[(size_t)(sn * 256 + c0 + row) * DM + k0 + i] = (u16)f2bf(acc[r]); }
        }
    }
    const int gt = C.bid * 512 + C.tid, NT = C.G * 512;
    for (int i = gt; i < 2 * (4 * 2 * 512 * 512 / 8); i += NT) {
        const int which = i >= (4 * 2 * 512 * 512 / 8), i8 = which ? i - (4 * 2 * 512 * 512 / 8) : i;
        const int c8 = i8 & 63, key = (i8 >> 6) & 511, l = (i8 >> 15) & 1, b = i8 >> 16;
        const float* src = (which ? C.cache_v : C.cache_k) + ((size_t)((b * 2 + l) * 512 + key)) * 512 + c8 * 8;
        const f32x4 v0 = *(const f32x4*)src, v1 = *(const f32x4*)(src + 4);
        u32x4 o; o.x = pk2(v0[0], v0[1]); o.y = pk2(v0[2], v0[3]); o.z = pk2(v1[0], v1[1]); o.w = pk2(v1[2], v1[3]);
        *(u32x4*)(WSP(u16, which ? WS_CV : WS_CK) + ((size_t)((l * 4 + b) * 512 + key)) * 512 + c8 * 8) = o;
    }
    for (int i = gt; i < (2048 * 4096 + 256 * 512) / 8; i += NT) {
        const bool smp = i < 2048 * 4096 / 8; const int i8 = smp ? i : i - 2048 * 4096 / 8;
        const int N = smp ? 2048 : 256, lg = smp ? 11 : 8; const int k = i8 >> (lg - 2), n2 = (i8 & ((1 << (lg - 2)) - 1)) * 8;
        const float sc = smp ? 0.0013810679320049757f : 0.00390625f, invN = 1.f / (float)N;
        float v[8];
#pragma unroll
        for (int q = 0; q < 8; ++q) { const int nn = n2 + q, n = nn & (N - 1), sp = nn >> lg; const float fr = (float)((k * n) & (N - 1)) * invN;
            v[q] = sp ? -__builtin_amdgcn_sinf(fr) * sc : __builtin_amdgcn_cosf(fr) * sc; }
        u32x4 o; o.x = pk2(v[0], v[1]); o.y = pk2(v[2], v[3]); o.z = pk2(v[4], v[5]); o.w = pk2(v[6], v[7]);
        *(u32x4*)(WSP(u16, smp ? WS_DS : WS_DC) + (size_t)k * (2 * N) + n2) = o;
    }
    if (gt < 1024) { const int pos = gt >> 4, f = gt & 15; const float inv = powf(10000.f, -(float)f / 16.f), a = (float)pos * inv; WSP(f32x2, WS_ROPE)[gt] = (f32x2){cosf(a), sinf(a)}; }
    if (gt < 2) { const float* lv = C.lam_vec + gt * 256; float s1 = 0, s2 = 0; for (int i = 0; i < 64; ++i) { s1 += lv[i] * lv[64 + i]; s2 += lv[128 + i] * lv[192 + i]; }
        WSP(float, WS_LAM)[gt] = expf(s1) - expf(s2) + (0.8f - 0.6f * expf(-0.3f * (float)gt)); }
}

__device__ __forceinline__ void phase_p0b(const Ctx& C) {
    LAS float* ldsf = (LAS float*)C.lds;
    LAS float* sh = ldsf;
    LAS float* red = ldsf + 10240;
    const float* MOD = WSP(float, WS_MOD);
    for (int i = C.tid; i < 2 * 5 * DM; i += 512) { const int lb = i >> 10, k = i & 1023; sh[i] = MOD[lb * 3072 + k]; }
    __syncthreads();
    float* SW = WSP(float, WS_SW);
    for (int it = C.bid; it < 104; it += C.G) {
        const int l = it / 52, o = 256 + (it % 52) * 64 + C.lane;
        const float* W = C.w_in + (size_t)l * DM * INDIM + o; const LAS float* s = sh + l * 5120;
        float a0 = 0, a1 = 0, a2 = 0, a3 = 0, a4 = 0;
        const int kb = C.wave * 128;
#pragma unroll 4
        for (int k = kb; k < kb + 128; ++k) { const float w = W[(size_t)k * INDIM]; a0 += s[k] * w; a1 += s[1024 + k] * w; a2 += s[2048 + k] * w; a3 += s[3072 + k] * w; a4 += s[4096 + k] * w; }
        LAS float* rd = red + C.wave * 320 + C.lane; rd[0] = a0; rd[64] = a1; rd[128] = a2; rd[192] = a3; rd[256] = a4;
        __syncthreads();
        if (C.tid < 320) { float sm = 0; for (int w = 0; w < 8; ++w) sm += red[w * 320 + C.tid]; const int bb = C.tid >> 6, oo = 256 + (it % 52) * 64 + (C.tid & 63);
            SW[(l * 5 + bb) * NMAIN + tile_col(oo)] = sm; }
        __syncthreads();
    }
    const int gw = C.bid * 8 + C.wave, NGW = C.G * 8;
    float* SWF = WSP(float, WS_SWF);
    for (int it = gw; it < 2 * NFT; it += NGW) {
        const int l = it >> 9, cc = it & 511; const u16* wr = WSP(u16, WS_WFT) + ((size_t)l * NFT + cc) * DM + C.lane * 16;
        const u32x4 w0 = *(const u32x4*)wr, w1 = *(const u32x4*)(wr + 8); const LAS float* s = sh + l * 5120 + C.lane * 16;
        float wv[16] = {bflo(w0.x), bfhi(w0.x), bflo(w0.y), bfhi(w0.y), bflo(w0.z), bfhi(w0.z), bflo(w0.w), bfhi(w0.w), bflo(w1.x), bfhi(w1.x), bflo(w1.y), bfhi(w1.y), bflo(w1.z), bfhi(w1.z), bflo(w1.w), bfhi(w1.w)};
#pragma unroll
        for (int bb = 0; bb < 5; ++bb) { float a = 0;
#pragma unroll
            for (int q = 0; q < 16; ++q) a += wv[q] * s[bb * 1024 + q];
            a = wave_sum(a); if (C.lane == 0) SWF[(l * 5 + bb) * NFT + cc] = a; }
    }
    u16* AP = WSP(u16, WS_AP); float* PART = WSP(float, WS_PART);
    for (int r = gw; r < NTOK; r += NGW) {
        const float* xr = (r < NCTX ? C.x_prompt + (size_t)r * DM : C.x_sample + (size_t)(r - NCTX) * DM); const int bb = modid(r);
        float ss = 0;
#pragma unroll
        for (int j = 0; j < 4; ++j) { const int k = 256 * j + 4 * C.lane; const f32x4 v = *(const f32x4*)(xr + k), g = *(const f32x4*)(C.norm_g + k), sc = *(const f32x4*)(MOD + bb * 3072 + 1024 + k);
            ss += (v[0] * v[0] + v[1] * v[1]) + (v[2] * v[2] + v[3] * v[3]);
            u32x2 o; o.x = pk2(v[0] * g[0] * (1.f + sc[0]), v[1] * g[1] * (1.f + sc[1])); o.y = pk2(v[2] * g[2] * (1.f + sc[2]), v[3] * g[3] * (1.f + sc[3]));
            *(u32x2*)(AP + (size_t)r * DM + k) = o; }
        ss = wave_sum(ss);
        if (C.lane < 16) PART[(size_t)r * 16 + C.lane] = C.lane == 0 ? ss : 0.f;
    }
}
__device__ __forceinline__ float dotbf(const u16* a, const u16* b, int K) {
    float s0 = 0, s1 = 0, s2 = 0, s3 = 0;
    for (int k = 0; k < K; k += 8) {
        const u32x4 x = *(const u32x4*)(a + k), y = *(const u32x4*)(b + k);
        s0 += bflo(x.x) * bflo(y.x) + bfhi(x.x) * bfhi(y.x); s1 += bflo(x.y) * bflo(y.y) + bfhi(x.y) * bfhi(y.y);
        s2 += bflo(x.z) * bflo(y.z) + bfhi(x.z) * bfhi(y.z); s3 += bflo(x.w) * bflo(y.w) + bfhi(x.w) * bfhi(y.w);
    }
    return (s0 + s1) + (s2 + s3);
}
__device__ __forceinline__ float row_rstd(const float* PART, int r) {
    const f32x4* p = (const f32x4*)(PART + (size_t)r * 16); const f32x4 a = p[0], b = p[1], c = p[2], d = p[3];
    const float s = ((a[0] + a[1]) + (a[2] + a[3])) + ((b[0] + b[1]) + (b[2] + b[3])) + ((c[0] + c[1]) + (c[2] + c[3])) + ((d[0] + d[1]) + (d[2] + d[3]));
    return 1.f / sqrtf(s * (1.f / 1024.f) + EPS);
}
__device__ __forceinline__ size_t newkv_off(int r, int l, int c) { const int b = r >> 8, t = r & 255; return ((size_t)((b * 2 + l) * 256 + t)) * 512 + c; }

__device__ __forceinline__ void naive_p1(const Ctx& C, int l) {
    const u16* AP = WSP(u16, WS_AP); const u16* WM = WSP(u16, WS_WMT) + (size_t)l * NMAIN * DM; const u16* WF = WSP(u16, WS_WFT) + (size_t)l * NFT * DM;
    const float* PART = WSP(float, WS_PART); const float* SW = WSP(float, WS_SW) + l * 5 * NMAIN; const float* SWF = WSP(float, WS_SWF) + l * 5 * NFT;
    const f32x2* ROPE = WSP(f32x2, WS_ROPE);
    u16 *SGA = WSP(u16, WS_SGA), *U = WSP(u16, WS_U), *WC = WSP(u16, WS_WC), *Q = WSP(u16, WS_Q), *K = WSP(u16, WS_K), *V = WSP(u16, WS_V), *SGC = WSP(u16, WS_SGC);
    const long gt = (long)C.bid * 512 + C.tid, NT = (long)C.G * 512;
    for (long idx = gt; idx < (long)NTOK * 3072; idx += NT) {
        const int r = (int)(idx / 3072), o = (int)(idx % 3072), bb = modid(r); const float rs = row_rstd(PART, r); const u16* a = AP + (size_t)r * DM;
#define ZM(j) (rs * dotbf(a, WM + (size_t)(j) * DM, DM) + SW[bb * NMAIN + (j)])
        if (o < 256) { SGA[(size_t)r * 256 + o] = (u16)f2bf(silu(ZM(inv_o8(o)))); }
        else if (o < 512) { const int ch = o - 256, t = ch >> 6, c6 = ch & 63, wc = c6 >> 4, fq = (c6 >> 2) & 3, e = c6 & 3; const int jb = 256 * (1 + t) + 32 * wc + 4 * fq + e;
            const float bg = ZM(jb), cg = ZM(jb + 16), hc = ZM(jb + 128), gb = ZM(jb + 144);
            U[(size_t)r * 256 + ch] = (u16)f2bf(cg * hc); WC[(size_t)r * 256 + ch] = (u16)f2bf(bg * silu(gb)); }
        else if (o < 1536) { const bool isk = o >= 1024; const int c = isk ? o - 1024 : o - 512; const int jb = isk ? 1792 : 1280; float z = ZM(jb + c);
            if (r >= NCTX) { const float zp = ZM(jb + (c ^ 16)); const int t = (r - NCTX) & 2047, w = c & 63, axis = w >> 5, i = w & 31, pos = axis ? (t & 63) : (t >> 6); const f32x2 cs = ROPE[pos * 16 + (i & 15)];
                z = (i < 16) ? z * cs.x - zp * cs.y : z * cs.x + zp * cs.y; }
            else if (isk) C.out[OUT_NK + newkv_off(r, l, c)] = z;
            if (isk) K[(size_t)r * 512 + c] = (u16)f2bf(z); else Q[(size_t)r * 512 + c] = (u16)f2bf(z * QSCALE); }
        else if (o < 2048) { const int c = o - 1536; const float z = ZM(2304 + (c >> 8) * 256 + inv_o8(c & 255)); V[(size_t)r * 512 + c] = (u16)f2bf(z); if (r < NCTX) C.out[OUT_NV + newkv_off(r, l, c)] = z; }
        else if (o < 2560) { const int c = o - 2048; SGC[(size_t)r * 512 + c] = (u16)f2bf(silu(ZM(2816 + (c >> 8) * 256 + inv_o8(c & 255)))); }
        else { const int cc = o - 2560, ch = cc & 255, sp = cc >> 8; const float z = rs * dotbf(a, WF + (size_t)cc * DM, DM) + SWF[bb * NFT + cc];
            if (r < NCTX) { const int b = r >> 8, n = r & 255; WSP(u16, WS_XTC)[((size_t)(b * 256 + ch)) * 512 + sp * 256 + n] = (u16)f2bf(z); }
            else { const int b = (r - NCTX) >> 11, n = (r - NCTX) & 2047; WSP(u16, WS_XTS)[((size_t)(b * 256 + ch)) * 4096 + sp * 2048 + n] = (u16)f2bf(z); } }
#undef ZM
    }
}

__device__ __forceinline__ void naive_fourier(const Ctx& C) {
    const long gt = (long)C.bid * 512 + C.tid, NT = (long)C.G * 512; const u16* SGA = WSP(u16, WS_SGA); u16* Y = WSP(u16, WS_YMIX);
    for (long idx = gt; idx < (long)NTOK * 256; idx += NT) {
        const int r = (int)(idx >> 8), c = (int)(idx & 255); float y;
        if (r < NCTX) { const int b = r >> 8, k = r & 255; y = dotbf(WSP(u16, WS_DC) + (size_t)k * 512, WSP(u16, WS_XTC) + ((size_t)(b * 256 + c)) * 512, 512); }
        else { const int b = (r - NCTX) >> 11, k = (r - NCTX) & 2047; y = dotbf(WSP(u16, WS_DS) + (size_t)k * 4096, WSP(u16, WS_XTS) + ((size_t)(b * 256 + c)) * 4096, 4096); }
        Y[(size_t)r * DM + c] = (u16)f2bf(y * bf2f(SGA[(size_t)r * 256 + c]));
    }
}
__device__ __forceinline__ void conv_items(const Ctx& C, int l, long first, long step, long end = (long)NTOK * 32) {
    const u16* U = WSP(u16, WS_U); const u16* WCb = WSP(u16, WS_WC); u16* Y = WSP(u16, WS_YMIX); const float* cw = C.conv_w + l * 768; const float* cb = C.conv_b + l * 256;
    for (long idx = first; idx < end; idx += step) {
        const int r = (int)(idx >> 5), c0 = (int)(idx & 31) * 8; const int t = r < NCTX ? (r & 255) : ((r - NCTX) & 2047), L = r < NCTX ? 256 : 2048;
        const u32x4 z = {0u, 0u, 0u, 0u};
        const u32x4 um = t > 0 ? *(const u32x4*)(U + (size_t)(r - 1) * 256 + c0) : z, u0 = *(const u32x4*)(U + (size_t)r * 256 + c0), up = t < L - 1 ? *(const u32x4*)(U + (size_t)(r + 1) * 256 + c0) : z;
        const u32x4 wv = *(const u32x4*)(WCb + (size_t)r * 256 + c0);
        unsigned o[4];
#pragma unroll
        for (int q = 0; q < 4; ++q) { const int ca = c0 + 2 * q, cb2 = ca + 1;
            const float ya = bflo(um[q]) * cw[ca] + bflo(u0[q]) * cw[256 + ca] + bflo(up[q]) * cw[512 + ca] + cb[ca];
            const float yb = bfhi(um[q]) * cw[cb2] + bfhi(u0[q]) * cw[256 + cb2] + bfhi(up[q]) * cw[512 + cb2] + cb[cb2];
            o[q] = pk2(ya * bflo(wv[q]), yb * bfhi(wv[q])); }
        *(u32x4*)(Y + (size_t)r * DM + 256 + c0) = (u32x4){o[0], o[1], o[2], o[3]};
    }
}
__device__ __forceinline__ void naive_attn(const Ctx& C, int l) {
    const int gw = C.bid * 8 + C.wave, NGW = C.G * 8, lane = C.lane;
    const u16 *Q = WSP(u16, WS_Q), *K = WSP(u16, WS_K), *V = WSP(u16, WS_V), *SGC = WSP(u16, WS_SGC); u16* Y = WSP(u16, WS_YMIX);
    const float lam = WSP(float, WS_LAM)[l], lam_init = 0.8f - 0.6f * expf(-0.3f * (float)l);
    for (int task = gw; task < NTOK * 4; task += NGW) {
        const int r = task >> 2, h = task & 3; const u16* q = Q + (size_t)r * 512 + h * 128;
        int M, nc; const u16 *k0p, *v0p, *k1p, *v1p;
        if (r < NCTX) { const int b = r >> 8; M = 256; nc = 0; k0p = v0p = nullptr; k1p = K + (size_t)(b * 256) * 512 + h * 128; v1p = V + (size_t)(b * 256) * 512 + h * 128; }
        else { const int b = (r - NCTX) >> 11; M = 2560; nc = 512; k0p = WSP(u16, WS_CK) + ((size_t)((l * 4 + b) * 512)) * 512 + h * 128; v0p = WSP(u16, WS_CV) + ((size_t)((l * 4 + b) * 512)) * 512 + h * 128;
            k1p = K + (size_t)(NCTX + b * 2048) * 512 + h * 128; v1p = V + (size_t)(NCTX + b * 2048) * 512 + h * 128; }
        float m1 = -1e30f, m2 = -1e30f;
        for (int kk = 0; kk < M; kk += 64) { const int key = kk + lane; const u16* kp = key < nc ? k0p + (size_t)key * 512 : k1p + (size_t)(key - nc) * 512;
            m1 = fmaxf(m1, dotbf(q, kp, 64)); m2 = fmaxf(m2, dotbf(q + 64, kp + 64, 64)); }
        m1 = wave_max(m1); m2 = wave_max(m2);
        float l1 = 0, l2 = 0, o1a = 0, o1b = 0, o2a = 0, o2b = 0;
        for (int kk = 0; kk < M; kk += 64) { const int key = kk + lane; const u16* kp = key < nc ? k0p + (size_t)key * 512 : k1p + (size_t)(key - nc) * 512;
            const float p1 = exp2f(dotbf(q, kp, 64) - m1), p2 = exp2f(dotbf(q + 64, kp + 64, 64) - m2); l1 += p1; l2 += p2;
            const u16* vb = kk < nc ? v0p + (size_t)kk * 512 : v1p + (size_t)(kk - nc) * 512;
            for (int j = 0; j < 64; ++j) { const float a = __shfl(p1, j), b = __shfl(p2, j); const unsigned vv = *(const unsigned*)(vb + (size_t)j * 512 + 2 * lane);
                o1a += a * bflo(vv); o1b += a * bfhi(vv); o2a += b * bflo(vv); o2b += b * bfhi(vv); } }
        l1 = wave_sum(l1); l2 = wave_sum(l2);
        float oa = o1a / l1 - lam * (o2a / l2), ob = o1b / l1 - lam * (o2b / l2);
        const float ss = wave_sum(oa * oa + ob * ob), rs = (1.f - lam_init) / sqrtf(ss * (1.f / 128.f) + EPS);
        const float* g = C.subln_g + l * 128 + 2 * lane; const unsigned gc = *(const unsigned*)(SGC + (size_t)r * 512 + h * 128 + 2 * lane);
        *(unsigned*)(Y + (size_t)r * DM + 512 + h * 128 + 2 * lane) = pk2(oa * rs * g[0] * bflo(gc), ob * rs * g[1] * bfhi(gc));
    }
}
__device__ __forceinline__ void naive_p3(const Ctx& C, int l) {
    const int gw = C.bid * 8 + C.wave, NGW = C.G * 8, lane = C.lane;
    const u16* Y = WSP(u16, WS_YMIX); const u16* WO = WSP(u16, WS_WOT) + (size_t)l * DM * DM; const float* MOD = WSP(float, WS_MOD);
    float* X1 = WSP(float, WS_X1); u16* AP = WSP(u16, WS_AP); float* PART = WSP(float, WS_PART);
    for (int r = gw; r < NTOK; r += NGW) {
        const int bb = modid(r); const float* gate = MOD + (l * 5 + bb) * 3072 + 2048;
        const float* xold = l == 0 ? (r < NCTX ? C.x_prompt + (size_t)r * DM : C.x_sample + (size_t)(r - NCTX) * DM) : X1 + (size_t)r * DM;
        float* xnew = l == 0 ? X1 + (size_t)r * DM : C.out + (size_t)r * DM;
        float ss = 0;
#pragma unroll 1
        for (int j = 0; j < 16; ++j) { const int c = 64 * j + lane; const float acc = dotbf(Y + (size_t)r * DM, WO + (size_t)c * DM, DM); const float v = xold[c] + gate[c] * acc; xnew[c] = v; ss += v * v; }
        ss = wave_sum(ss);
        if (l == 0) {
            const float* sc = MOD + (5 + bb) * 3072 + 1024;
#pragma unroll 1
            for (int j = 0; j < 16; ++j) { const int c = 64 * j + lane; AP[(size_t)r * DM + c] = (u16)f2bf(xnew[c] * C.norm_g[DM + c] * (1.f + sc[c])); }
            if (lane < 16) PART[(size_t)r * 16 + lane] = lane == 0 ? ss : 0.f;
        } else {
            const float rs = 1.f / sqrtf(ss * (1.f / 1024.f) + EPS);
#pragma unroll 1
            for (int j = 0; j < 16; ++j) { const int c = 64 * j + lane; xnew[c] = xnew[c] * rs * C.final_g[c]; }
        }
    }
}
namespace pg8 {
#define PG8_LAS __attribute__((address_space(3)))
typedef unsigned short bf16_t;
constexpr int BM = 256, BK = 64, HALF = 128, HTB = HALF * BK * 2, STAGE_BYTES = 8 * HTB;
__host__ __device__ __forceinline__ int lds_byte(int r, int c) { const int st = (r >> 4) * 2 + (c >> 5), rr = r & 15, cc = c & 31, ob = rr * 64 + cc * 2; return st * 1024 + (ob ^ (((ob >> 9) & 1) << 5)); }
__host__ __device__ __forceinline__ void stage_rc(int b, int& R, int& C) { const int st = b / 1024, sb = b % 1024, swz = sb ^ (((sb >> 9) & 1) << 5); R = (st >> 1) * 16 + swz / 64; C = (st & 1) * 32 + (swz % 64) / 2; }
__host__ __device__ __forceinline__ int perm32(int rho) { const int n = rho >> 4, i = rho & 15; return 8 * (i >> 2) + 4 * n + (i & 3); }
struct Unit { const char* A; const char* B; int kind, pm, pn, aux; };
template <class Epi, class Sched, bool ALIGN_EPI = false, bool SP2 = false>
__device__ __forceinline__ void gemm_phase(PG8_LAS unsigned char* lds, const int K, const Sched& S, const Epi& E) {
    int tid = threadIdx.x; asm volatile("" : "+v"(tid));
    const int wid = __builtin_amdgcn_readfirstlane(tid >> 6), lane = tid & 63, wr = wid >> 2, wc = wid & 3, fr = lane & 15, fq = lane >> 4;
    const int nt = K / BK;
    unsigned voffA[2], voffB[2];
#pragma unroll
    for (int i = 0; i < 2; ++i) { int R, C; stage_rc(tid * 16 + i * 8192, R, C); const int Rb = Epi::PERM ? ((R & ~31) + perm32(R & 31)) : R;
        voffA[i] = (unsigned)(R * K + C) * 2u; voffB[i] = (unsigned)(Rb * K + C) * 2u; }
    const size_t kstep = (size_t)(BK * 2);
    const size_t hstep = (size_t)HALF * K * 2;
    const size_t tstep = 2 * hstep;
    const unsigned ldsw = (unsigned)wid * 1024u;
    const int aoff = lds_byte(wr * 64 + fr, fq * 8), boff = lds_byte(wc * 32 + fr, fq * 8);
#define PG8_SA(b, h) (((b) * 2 + (h)) * HTB)
#define PG8_SB(b, h) ((4 + (b) * 2 + (h)) * HTB)
#define PG8_STAGE(bufoff, gbase, voff) do { _Pragma("unroll") for (int _i = 0; _i < 2; ++_i) \
        __builtin_amdgcn_global_load_lds((const unsigned*)((const char*)(gbase) + (voff)[_i]), (PG8_LAS unsigned*)(lds + (bufoff) + ldsw + _i * 8192), 16, 0, 0); } while (0)
#define PG8_LDA(dst, b, h) do { _Pragma("unroll") for (int m = 0; m < 4; ++m) _Pragma("unroll") for (int k = 0; k < 2; ++k) dst[m][k] = *(const PG8_LAS bf16x8*)(lds + PG8_SA(b, h) + aoff + m * 2048 + k * 1024); } while (0)
#define PG8_LDB(dst, b, h) do { _Pragma("unroll") for (int n = 0; n < 2; ++n) _Pragma("unroll") for (int k = 0; k < 2; ++k) dst[n][k] = *(const PG8_LAS bf16x8*)(lds + PG8_SB(b, h) + boff + n * 2048 + k * 1024); } while (0)
#define PG8_MMA(ai, bj, At, Bt) do { __builtin_amdgcn_s_setprio(1); _Pragma("unroll") for (int m = 0; m < 4; ++m) _Pragma("unroll") for (int n = 0; n < 2; ++n) _Pragma("unroll") for (int k = 0; k < 2; ++k) \
        acc[ai][bj][m][n] = __builtin_amdgcn_mfma_f32_16x16x32_bf16(Bt[n][k], At[m][k], acc[ai][bj][m][n], 0, 0, 0); __builtin_amdgcn_s_setprio(0); } while (0)
#define PG8_WAIT_V(n) asm volatile("s_waitcnt vmcnt(" #n ")" ::: "memory")
#define PG8_WAIT_L(n) asm volatile("s_waitcnt lgkmcnt(" #n ")" ::: "memory")
#define PG8_BAR __builtin_amdgcn_s_barrier()
#define PG8_SCHED __builtin_amdgcn_sched_barrier(0)
    Unit cur, nxt; int ui = 0;
    if (!S.next(0, cur)) return;
    f32x4 acc[2][2][4][2];
#pragma unroll
    for (int a = 0; a < 2; ++a)
#pragma unroll
        for (int b = 0; b < 2; ++b)
#pragma unroll
            for (int m = 0; m < 4; ++m)
#pragma unroll
                for (int n = 0; n < 2; ++n) acc[a][b][m][n] = (f32x4){0.f, 0.f, 0.f, 0.f};
    bf16x8 At[4][2], B0[2][2], B1[2][2];
    const char* cA = cur.A; const char* cB = cur.B;
    S.a_ready(cur);
    if constexpr (SP2) {
        PG8_STAGE(PG8_SB(0, 0), cB, voffB); PG8_STAGE(PG8_SB(0, 1), cB + hstep, voffB); PG8_STAGE(PG8_SA(0, 0), cA, voffA); PG8_STAGE(PG8_SA(0, 1), cA + hstep, voffA);
        if (wr == 1) PG8_BAR;
        PG8_WAIT_V(2); PG8_BAR;
        PG8_STAGE(PG8_SB(1, 0), cB + kstep, voffB); PG8_STAGE(PG8_SA(1, 0), cA + kstep, voffA); PG8_STAGE(PG8_SB(1, 1), cB + hstep + kstep, voffB);
        PG8_WAIT_V(6); PG8_BAR;
    } else {
        PG8_STAGE(PG8_SB(0, 0), cB, voffB); PG8_STAGE(PG8_SA(0, 0), cA, voffA); PG8_STAGE(PG8_SB(0, 1), cB + hstep, voffB); PG8_STAGE(PG8_SA(0, 1), cA + hstep, voffA);
        if (wr == 1) PG8_BAR;
        PG8_WAIT_V(4); PG8_BAR;
        PG8_STAGE(PG8_SB(1, 0), cB + kstep, voffB); PG8_STAGE(PG8_SA(1, 0), cA + kstep, voffA); PG8_STAGE(PG8_SB(1, 1), cB + hstep + kstep, voffB);
        PG8_WAIT_V(6); PG8_BAR;
    }
    for (;;) {
        const bool has_next = S.next(ui + 1, nxt);
        const char* nA = has_next ? nxt.A : cA; const char* nB = has_next ? nxt.B : cB;
        for (int t = 0; t < nt; t += 2) {
            const bool last = (t == nt - 2);
            const char* a1 = cA + (size_t)(t + 1) * kstep;
            const char* a2 = last ? nA : cA + (size_t)(t + 2) * kstep; const char* b2 = last ? nB : cB + (size_t)(t + 2) * kstep;
            const char* a3 = a2 + kstep; const char* b3 = b2 + kstep;
            if (last && has_next) S.a_ready(nxt);
            if constexpr (SP2) {
            PG8_LDB(B0, 0, 0); PG8_LDB(B1, 0, 1); PG8_SCHED; PG8_LDA(At, 0, 0); PG8_STAGE(PG8_SA(1, 1), a1 + hstep, voffA);
            PG8_WAIT_V(8); PG8_WAIT_L(0); PG8_BAR; PG8_MMA(0, 0, At, B0); PG8_MMA(0, 1, At, B1); PG8_BAR; PG8_SCHED;
            PG8_LDA(At, 0, 1); PG8_STAGE(PG8_SB(0, 0), b2, voffB); PG8_STAGE(PG8_SB(0, 1), b2 + hstep, voffB); PG8_STAGE(PG8_SA(0, 0), a2, voffA);
            PG8_WAIT_V(8); PG8_WAIT_L(0); PG8_BAR; PG8_MMA(1, 0, At, B0); PG8_MMA(1, 1, At, B1); PG8_BAR; PG8_SCHED;
            PG8_LDB(B0, 1, 0); PG8_LDB(B1, 1, 1); PG8_SCHED; PG8_LDA(At, 1, 0); PG8_STAGE(PG8_SA(0, 1), a2 + hstep, voffA);
            PG8_WAIT_V(8); PG8_WAIT_L(0); PG8_BAR; PG8_MMA(0, 0, At, B0); PG8_MMA(0, 1, At, B1); PG8_BAR; PG8_SCHED;
            PG8_LDA(At, 1, 1); PG8_STAGE(PG8_SB(1, 0), b3, voffB); PG8_STAGE(PG8_SB(1, 1), b3 + hstep, voffB); PG8_STAGE(PG8_SA(1, 0), a3, voffA);
            PG8_WAIT_V(8); PG8_WAIT_L(0); PG8_BAR; PG8_MMA(1, 0, At, B0); PG8_MMA(1, 1, At, B1); PG8_BAR; PG8_SCHED;
            } else {
            PG8_LDB(B0, 0, 0); PG8_SCHED; PG8_LDA(At, 0, 0); PG8_STAGE(PG8_SA(1, 1), a1 + hstep, voffA);
            PG8_WAIT_L(8); PG8_BAR; PG8_WAIT_L(0); PG8_MMA(0, 0, At, B0); PG8_BAR; PG8_SCHED;
            PG8_LDB(B1, 0, 1); PG8_STAGE(PG8_SB(0, 0), b2, voffB);
            PG8_BAR; PG8_WAIT_L(0); PG8_MMA(0, 1, At, B1); PG8_BAR;
            PG8_LDA(At, 0, 1); PG8_STAGE(PG8_SA(0, 0), a2, voffA);
            PG8_BAR; PG8_WAIT_L(0); PG8_MMA(1, 0, At, B0); PG8_BAR; PG8_SCHED;
            PG8_STAGE(PG8_SB(0, 1), b2 + hstep, voffB);
            PG8_WAIT_V(6); PG8_BAR; PG8_MMA(1, 1, At, B1); PG8_BAR;
            PG8_LDB(B0, 1, 0); PG8_SCHED; PG8_LDA(At, 1, 0); PG8_STAGE(PG8_SA(0, 1), a2 + hstep, voffA);
            PG8_WAIT_L(8); PG8_BAR; PG8_WAIT_L(0); PG8_MMA(0, 0, At, B0); PG8_BAR; PG8_SCHED;
            PG8_LDB(B1, 1, 1); PG8_STAGE(PG8_SB(1, 0), b3, voffB);
            PG8_BAR; PG8_WAIT_L(0); PG8_MMA(0, 1, At, B1); PG8_BAR;
            PG8_LDA(At, 1, 1); PG8_STAGE(PG8_SA(1, 0), a3, voffA);
            PG8_BAR; PG8_WAIT_L(0); PG8_MMA(1, 0, At, B0); PG8_BAR; PG8_SCHED;
            PG8_STAGE(PG8_SB(1, 1), b3 + hstep, voffB);
            PG8_WAIT_V(6); PG8_BAR; PG8_MMA(1, 1, At, B1); PG8_BAR;
            }
        }
        if constexpr (ALIGN_EPI) { if (wr == 0) PG8_BAR; }
        if constexpr (!Epi::AFTER_DRAIN) { E(acc, cur, wr, wc, fr, fq); S.done(cur); }
        if (!has_next) break;
#pragma unroll
        for (int a = 0; a < 2; ++a)
#pragma unroll
            for (int b = 0; b < 2; ++b)
#pragma unroll
                for (int m = 0; m < 4; ++m)
#pragma unroll
                    for (int n = 0; n < 2; ++n) acc[a][b][m][n] = (f32x4){0.f, 0.f, 0.f, 0.f};
        cur = nxt; cA = nA; cB = nB; ++ui;
        if constexpr (ALIGN_EPI) { if (wr == 1) PG8_BAR; }
    }
    PG8_WAIT_V(0);
    if constexpr (!ALIGN_EPI) { if (wr == 0) PG8_BAR; }
    PG8_BAR;
    if constexpr (Epi::AFTER_DRAIN) { E.fused(acc, cur, wr, wc, fr, fq, lds, wid, lane); S.done(cur); }
#undef PG8_SA
#undef PG8_SB
#undef PG8_STAGE
#undef PG8_LDA
#undef PG8_LDB
#undef PG8_MMA
#undef PG8_WAIT_V
#undef PG8_WAIT_L
#undef PG8_BAR
#undef PG8_SCHED
}
}
namespace attn {
constexpr int KVBLK = 64;
constexpr int SHM_V = KVBLK * 128 * 2, SHM_K = KVBLK * 128 * 2;
constexpr int OFF_V = 0, OFF_K = 2 * SHM_V, OFF_WS = 2 * SHM_V + 2 * SHM_K, OST_STRIDE = 132;
#ifndef ATTN_THR
#define ATTN_THR 8.f
#endif
constexpr float THR2 = ATTN_THR * 1.4426950408889634f;
#define KSWZ(row, colB) ((row) * 256 + ((colB) ^ (((row) & 7) << 4)))
#define SBAR() __builtin_amdgcn_sched_barrier(0)
__device__ __forceinline__ int crow(int r, int hi) { return (r & 3) + 8 * (r >> 2) + 4 * hi; }
__device__ __forceinline__ unsigned cvtpk(float lo, float hi) { unsigned r; asm volatile("v_cvt_pk_bf16_f32 %0, %1, %2" : "=v"(r) : "v"(lo), "v"(hi)); return r; }

__device__ __forceinline__ void partialSM(f32x16& p0, f32x16& p1, float& m_reg, float& mn, float& alpha) {
  float pmax = p0[0];
#pragma unroll
  for (int r = 1; r < 16; ++r) pmax = fmaxf(pmax, p0[r]);
#pragma unroll
  for (int r = 0; r < 16; ++r) pmax = fmaxf(pmax, p1[r]);
  { auto rr = __builtin_amdgcn_permlane32_swap(__float_as_uint(pmax), __float_as_uint(pmax), false, false);
    pmax = fmaxf(__uint_as_float(rr[0]), __uint_as_float(rr[1])); }
  if (__builtin_expect(__all(pmax - m_reg <= THR2), 1)) { mn = m_reg; alpha = 1.f; }
  else { mn = fmaxf(m_reg, pmax); alpha = __builtin_amdgcn_exp2f(m_reg - mn); m_reg = mn; }
#pragma unroll
  for (int r = 0; r < 16; ++r) p0[r] = p0[r] - mn;
#pragma unroll
  for (int r = 0; r < 16; ++r) p1[r] = p1[r] - mn;
#pragma unroll
  for (int r = 0; r < 16; ++r) p0[r] = __builtin_amdgcn_exp2f(p0[r]);
}
__device__ __forceinline__ void finishSM(f32x16& p0, f32x16& p1, float alpha, float& l_reg, bf16x8& pa0, bf16x8& pa1, bf16x8& pa2, bf16x8& pa3) {
#pragma unroll
  for (int r = 0; r < 16; ++r) p1[r] = __builtin_amdgcn_exp2f(p1[r]);
  float ps = 0;
#pragma unroll
  for (int r = 0; r < 16; ++r) ps += p0[r];
#pragma unroll
  for (int r = 0; r < 16; ++r) ps += p1[r];
  { auto rr = __builtin_amdgcn_permlane32_swap(__float_as_uint(ps), __float_as_uint(ps), false, false);
    ps = __uint_as_float(rr[0]) + __uint_as_float(rr[1]); }
  l_reg = l_reg * alpha + ps;
#define PK4(P, BASE, OUT) do { unsigned a0 = cvtpk(P[BASE + 0], P[BASE + 1]), a1 = cvtpk(P[BASE + 2], P[BASE + 3]);   \
    unsigned b0 = cvtpk(P[BASE + 4], P[BASE + 5]), b1 = cvtpk(P[BASE + 6], P[BASE + 7]);                              \
    auto r0 = __builtin_amdgcn_permlane32_swap(a0, b0, false, false); auto r1 = __builtin_amdgcn_permlane32_swap(a1, b1, false, false); \
    u32x4 w = {r0[0], r1[0], r0[1], r1[1]}; OUT = *reinterpret_cast<bf16x8*>(&w); } while (0)
  PK4(p0, 0, pa0); PK4(p0, 8, pa1); PK4(p1, 0, pa2); PK4(p1, 8, pa3);
#undef PK4
}
__device__ __forceinline__ void qkt(f32x16& p0, f32x16& p1, const LAS unsigned char* Ks, const bf16x8* qr, int r32, int hi, int cbase) {
  p0 = f32x16{}; p1 = f32x16{};
#pragma unroll
  for (int d0 = 0; d0 < 4; ++d0) { const int cb = cbase + (d0 * 16 + hi * 8) * 2;
    const bf16x8 b0 = *reinterpret_cast<const LAS bf16x8*>(Ks + KSWZ(r32, cb));
    const bf16x8 b1 = *reinterpret_cast<const LAS bf16x8*>(Ks + KSWZ(32 + r32, cb));
    p0 = __builtin_amdgcn_mfma_f32_32x32x16_bf16(b0, qr[d0], p0, 0, 0, 0);
    p1 = __builtin_amdgcn_mfma_f32_32x32x16_bf16(b1, qr[d0], p1, 0, 0, 0); }
}
__device__ __forceinline__ int v_st(int k, int c) { const int kk = (k & ~0xC) | ((k & 4) << 1) | ((k & 8) >> 1); return ((kk >> 3) * 4 + (c >> 5)) * 512 + ((kk & 7) * 32 + (c & 31)) * 2; }
__device__ __forceinline__ int v_rd_base(int lane) { return ((lane & 3) << 3) | (((lane >> 2) & 3) << 6) | (((lane >> 4) & 1) << 5) | (((lane >> 5) & 1) << 8); }
constexpr int v_rd_off(int d0, int ks, int half) { return d0 * 512 + ks * 4096 + half * 2048; }
template <int OFF> __device__ __forceinline__ s16x4 tr_read(int vb) {
  s16x4 r; asm volatile("ds_read_b64_tr_b16 %0, %1 offset:%2" : "=&v"(r) : "v"(vb), "i"(OFF) : "memory"); return r;
}
template <int D0> __device__ __forceinline__ void pv_one(f32x16& od, int vb, bf16x8 pa0, bf16x8 pa1, bf16x8 pa2, bf16x8 pa3) {
  const s16x4 l0 = tr_read<v_rd_off(D0, 0, 0)>(vb), h0 = tr_read<v_rd_off(D0, 0, 1)>(vb), l1 = tr_read<v_rd_off(D0, 1, 0)>(vb), h1 = tr_read<v_rd_off(D0, 1, 1)>(vb);
  const s16x4 l2 = tr_read<v_rd_off(D0, 2, 0)>(vb), h2 = tr_read<v_rd_off(D0, 2, 1)>(vb), l3 = tr_read<v_rd_off(D0, 3, 0)>(vb), h3 = tr_read<v_rd_off(D0, 3, 1)>(vb);
  asm volatile("s_waitcnt lgkmcnt(0)" ::: "memory"); SBAR();
#define PK(L, H) (bf16x8){L[0], L[1], L[2], L[3], H[0], H[1], H[2], H[3]}
  od = __builtin_amdgcn_mfma_f32_32x32x16_bf16(pa0, PK(l0, h0), od, 0, 0, 0);
  od = __builtin_amdgcn_mfma_f32_32x32x16_bf16(pa1, PK(l1, h1), od, 0, 0, 0);
  od = __builtin_amdgcn_mfma_f32_32x32x16_bf16(pa2, PK(l2, h2), od, 0, 0, 0);
  od = __builtin_amdgcn_mfma_f32_32x32x16_bf16(pa3, PK(l3, h3), od, 0, 0, 0);
#undef PK
}
__device__ __forceinline__ void pv_d0(f32x16* o, int vb, bf16x8 pa0, bf16x8 pa1, bf16x8 pa2, bf16x8 pa3) {
  pv_one<0>(o[0], vb, pa0, pa1, pa2, pa3); pv_one<1>(o[1], vb, pa0, pa1, pa2, pa3); pv_one<2>(o[2], vb, pa0, pa1, pa2, pa3); pv_one<3>(o[3], vb, pa0, pa1, pa2, pa3);
}

struct Item {
  const u16* Q;
  const u16 *Kc, *Vc;
  const u16 *Kn, *Vn;
  int nc, seq;
  const u16* SGC;
  u16* Y;
  const float* subln;
  float lam, post;
};

__device__ __forceinline__ void diff_attn_item(const Item& it, LAS unsigned char* lds) {
  int tid = threadIdx.x; asm volatile("" : "+v"(tid));
  const int wid = __builtin_amdgcn_readfirstlane(tid >> 6), lane = tid & 63, r32 = lane & 31, hi = lane >> 5, hf = wid >> 2, rg = wid & 3;
  LAS unsigned char* V_lds = lds + OFF_V; LAS unsigned char* K_lds = lds + OFF_K;
  LAS float* ws = (LAS float*)(lds + OFF_WS) + wid * 64; LAS float* li_l = ws; LAS float* al_l = ws + 32;
  float m_reg = -1e30f, l_reg = 0; f32x16 o[4] = {}; bf16x8 qr[4];
  const u16* Qw = it.Q + (size_t)(rg * 32 + r32) * 512 + hf * 64 + hi * 8;
#pragma unroll
  for (int d0 = 0; d0 < 4; ++d0) qr[d0] = *reinterpret_cast<const bf16x8*>(Qw + d0 * 16);
  const int cbase = hf * 128;
  const int sr = tid >> 4, sc = (tid & 15) * 8, vst0 = v_st(sr, sc), vst1 = v_st(32 + sr, sc);
  const int vb0 = (int)(uintptr_t)V_lds + v_rd_base(lane);
  struct { bf16x8 vs0, vs1, ks0, ks1; } sr_[2];
#define TILE_PTRS(k0, kp, vp) const u16* kp; const u16* vp; if ((k0) < it.nc) { kp = it.Kc + (size_t)(k0) * 512; vp = it.Vc + (size_t)(k0) * 512; } else { kp = it.Kn + (size_t)((k0) - it.nc) * 512; vp = it.Vn + (size_t)((k0) - it.nc) * 512; }
#define SLOAD(i, k0) do { TILE_PTRS(k0, kp_, vp_); sr_[i].vs0 = *reinterpret_cast<const bf16x8*>(vp_ + (size_t)sr * 512 + sc); sr_[i].vs1 = *reinterpret_cast<const bf16x8*>(vp_ + (size_t)(32 + sr) * 512 + sc); \
    sr_[i].ks0 = *reinterpret_cast<const bf16x8*>(kp_ + (size_t)sr * 512 + sc); sr_[i].ks1 = *reinterpret_cast<const bf16x8*>(kp_ + (size_t)(32 + sr) * 512 + sc); } while (0)
#define SWRITE(b, i) do { *(LAS bf16x8*)(V_lds + (b) * SHM_V + vst0) = sr_[i].vs0; *(LAS bf16x8*)(V_lds + (b) * SHM_V + vst1) = sr_[i].vs1; const int kc = sc * 2; \
    *(LAS bf16x8*)(K_lds + (b) * SHM_K + KSWZ(sr, kc)) = sr_[i].ks0; *(LAS bf16x8*)(K_lds + (b) * SHM_K + KSWZ(32 + sr, kc)) = sr_[i].ks1; } while (0)
#define SWAIT() asm volatile("s_waitcnt vmcnt(4)" ::: "memory")
#define RESC(a) do { if (__any((a) < 1.f)) { if (hi == 0) al_l[r32] = (a); asm volatile("s_waitcnt lgkmcnt(0)" ::: "memory"); \
    _Pragma("unroll") for (int d = 0; d < 4; ++d) _Pragma("unroll") for (int r = 0; r < 16; ++r) o[d][r] *= al_l[crow(r, hi)]; } } while (0)
  f32x16 pA0, pA1, pB0, pB1; float mnA, mnB, alA, alB; bf16x8 pa0, pa1, pa2, pa3; const int NT = it.seq / KVBLK;
  constexpr int SE = 0, SO = 1;
  SLOAD(SE, 0); asm volatile("s_waitcnt vmcnt(0)" ::: "memory"); SWRITE(0, SE); __syncthreads();
  qkt(pA0, pA1, K_lds, qr, r32, hi, cbase); partialSM(pA0, pA1, m_reg, mnA, alA);
  SLOAD(SO, KVBLK); if (2 < NT) SLOAD(SE, 2 * KVBLK);
  SWAIT(); SWRITE(1, SO); __syncthreads();
  for (int j = 1; j + 1 < NT; j += 2) {
    SBAR(); qkt(pB0, pB1, K_lds + SHM_K, qr, r32, hi, cbase);
    finishSM(pA0, pA1, alA, l_reg, pa0, pa1, pa2, pa3); SBAR();
    SLOAD(SO, (j + 2) * KVBLK); SBAR();
    pv_d0(o, vb0, pa0, pa1, pa2, pa3); partialSM(pB0, pB1, m_reg, mnB, alB);
    __syncthreads(); SWAIT(); SWRITE(0, SE);
    RESC(alB); __syncthreads();
    SBAR(); qkt(pA0, pA1, K_lds, qr, r32, hi, cbase);
    finishSM(pB0, pB1, alB, l_reg, pa0, pa1, pa2, pa3); SBAR();
    if (j + 3 < NT) SLOAD(SE, (j + 3) * KVBLK); SBAR();
    pv_d0(o, vb0 + SHM_V, pa0, pa1, pa2, pa3); partialSM(pA0, pA1, m_reg, mnA, alA);
    __syncthreads(); SWAIT(); SWRITE(1, SO);
    RESC(alA); __syncthreads();
  }
  SBAR(); qkt(pB0, pB1, K_lds + SHM_K, qr, r32, hi, cbase);
  finishSM(pA0, pA1, alA, l_reg, pa0, pa1, pa2, pa3); SBAR();
  pv_d0(o, vb0, pa0, pa1, pa2, pa3); partialSM(pB0, pB1, m_reg, mnB, alB);
  __syncthreads(); RESC(alB);
  finishSM(pB0, pB1, alB, l_reg, pa0, pa1, pa2, pa3); SBAR();
  pv_d0(o, vb0 + SHM_V, pa0, pa1, pa2, pa3);
  if (hi == 0) li_l[r32] = l_reg; asm volatile("s_waitcnt lgkmcnt(0)" ::: "memory");
  float rli[16];
  const float fac = hf ? -it.lam : 1.f;
#pragma unroll
  for (int r = 0; r < 16; ++r) rli[r] = fac * __builtin_amdgcn_rcpf(li_l[crow(r, hi)]);
  __syncthreads();
  LAS float* OST = (LAS float*)lds;
  if (hf == 1) {
#pragma unroll
    for (int r = 0; r < 16; ++r) { LAS float* rowp = OST + (rg * 32 + crow(r, hi)) * OST_STRIDE + r32;
#pragma unroll
      for (int d0 = 0; d0 < 4; ++d0) rowp[d0 * 32] = o[d0][r] * rli[r]; }
  }
  __syncthreads();
  if (hf == 0) {
#pragma unroll
    for (int r = 0; r < 16; ++r) { LAS float* rowp = OST + (rg * 32 + crow(r, hi)) * OST_STRIDE + r32;
#pragma unroll
      for (int d0 = 0; d0 < 4; ++d0) rowp[d0 * 32] += o[d0][r] * rli[r]; }
  }
  __syncthreads();
  { const int row = tid >> 2, seg = tid & 3; const LAS float* rp = OST + row * OST_STRIDE + seg * 32; f32x4 v[8]; float ss = 0;
#pragma unroll
    for (int i = 0; i < 8; ++i) { v[i] = *(const LAS f32x4*)(rp + 4 * i); ss += (v[i][0] * v[i][0] + v[i][1] * v[i][1]) + (v[i][2] * v[i][2] + v[i][3] * v[i][3]); }
    ss += __shfl_xor(ss, 1); ss += __shfl_xor(ss, 2);
    const float rs = it.post / sqrtf(ss * (1.f / 128.f) + EPS);
    const u16* gp = it.SGC + (size_t)row * 512 + seg * 32; u16* yp = it.Y + (size_t)row * 1024 + seg * 32; const float* sg = it.subln + seg * 32;
#pragma unroll
    for (int i = 0; i < 4; ++i) { const u32x4 g = *(const u32x4*)(gp + 8 * i); const f32x4 s0 = *(const f32x4*)(sg + 8 * i), s1 = *(const f32x4*)(sg + 8 * i + 4); const f32x4 a = v[2 * i], b = v[2 * i + 1];
      u32x4 w; w.x = pk2(a[0] * rs * s0[0] * bflo(g.x), a[1] * rs * s0[1] * bfhi(g.x)); w.y = pk2(a[2] * rs * s0[2] * bflo(g.y), a[3] * rs * s0[3] * bfhi(g.y));
      w.z = pk2(b[0] * rs * s1[0] * bflo(g.z), b[1] * rs * s1[1] * bfhi(g.z)); w.w = pk2(b[2] * rs * s1[2] * bflo(g.w), b[3] * rs * s1[3] * bfhi(g.w));
      *(u32x4*)(yp + 8 * i) = w; } }
  __syncthreads();
#undef TILE_PTRS
#undef SLOAD
#undef SWRITE
#undef SWAIT
#undef RESC
}
#undef KSWZ
#undef SBAR
}
using pg8::Unit;
typedef f32x4 Acc[2][2][4][2];
__device__ __forceinline__ float rstd_of(const float* PART, int r) { return row_rstd(PART, r); }
__device__ __forceinline__ u32x2 pack4(f32x4 v) { u32x2 o; o.x = pk2(v[0], v[1]); o.y = pk2(v[2], v[3]); return o; }
__device__ __forceinline__ u32x4 pack8(f32x4 a, f32x4 b) { u32x4 o; o.x = pk2(a[0], a[1]); o.y = pk2(a[2], a[3]); o.z = pk2(b[0], b[1]); o.w = pk2(b[2], b[3]); return o; }
__device__ __forceinline__ f32x4 silu4(f32x4 v) { return (f32x4){silu(v[0]), silu(v[1]), silu(v[2]), silu(v[3])}; }

struct EpiInProj {
    static constexpr bool PERM = false, AFTER_DRAIN = false;
    const LAS float* RT; const float *SW, *SWF; const f32x2* ROPE; u16 *SGA, *U, *WC, *Q, *K, *V, *SGC, *XTS, *XTC; float* out; int l;
    __device__ __forceinline__ void operator()(const Acc& acc, const Unit& u, int wr, int wc, int fr, int fq) const {
        asm volatile("" : "+v"(fr), "+v"(fq));
        if (u.kind == 0) {
            const int pm = u.pm, pn = u.pn, bb = modid(pm * 256); const bool smp = pm >= 16;
            f32x4 swv[2][2];
#pragma unroll
            for (int bj = 0; bj < 2; ++bj)
#pragma unroll
                for (int n = 0; n < 2; ++n) swv[bj][n] = *(const f32x4*)(SW + bb * NMAIN + pn * 256 + 128 * bj + 32 * wc + 16 * n + 4 * fq);
#pragma unroll
            for (int ai = 0; ai < 2; ++ai)
#pragma unroll
                for (int m = 0; m < 4; ++m) {
                    const int rl = 128 * ai + 64 * wr + 16 * m + fr, r = pm * 256 + rl; const float rs = RT[u.aux * 256 + rl];
                    f32x4 z[2][2];
#pragma unroll
                    for (int bj = 0; bj < 2; ++bj)
#pragma unroll
                        for (int n = 0; n < 2; ++n) z[bj][n] = acc[ai][bj][m][n] * rs + swv[bj][n];
                    if (pn == 0) {
#pragma unroll
                        for (int bj = 0; bj < 2; ++bj) *(u32x4*)(SGA + (size_t)r * 256 + 128 * bj + 32 * wc + 8 * fq) = pack8(silu4(z[bj][0]), silu4(z[bj][1]));
                    } else if (pn <= 4) {
                        const int ch = (pn - 1) * 64 + 16 * wc + 4 * fq;
                        *(u32x2*)(U + (size_t)r * 256 + ch) = pack4(z[0][1] * z[1][0]);
                        *(u32x2*)(WC + (size_t)r * 256 + ch) = pack4(z[0][0] * silu4(z[1][1]));
                    } else if (pn <= 8) {
                        const bool isk = pn >= 7; const int cb = (isk ? pn - 7 : pn - 5) * 256 + 32 * wc + 4 * fq;
                        if (smp) { const int t = (r - NCTX) & 2047, pos = (wc & 1) ? (t & 63) : (t >> 6); const f32x4* rp = (const f32x4*)(ROPE + pos * 16 + 4 * fq); const f32x4 c01 = rp[0], c23 = rp[1];
                            const f32x4 cs = {c01[0], c01[2], c23[0], c23[2]}, sn = {c01[1], c01[3], c23[1], c23[3]};
#pragma unroll
                            for (int bj = 0; bj < 2; ++bj) { const f32x4 t0 = z[bj][0], t1 = z[bj][1]; z[bj][0] = t0 * cs - t1 * sn; z[bj][1] = t1 * cs + t0 * sn; } }
                        else if (isk) {
#pragma unroll
                            for (int bj = 0; bj < 2; ++bj)
#pragma unroll
                                for (int n = 0; n < 2; ++n) *(f32x4*)(out + OUT_NK + newkv_off(r, l, cb + 128 * bj + 16 * n)) = z[bj][n]; }
                        u16* dst = Q + (isk ? (WS_K - WS_Q) / 2 : (size_t)0) + (size_t)r * 512 + cb; const float sc = isk ? 1.f : QSCALE;
#pragma unroll
                        for (int bj = 0; bj < 2; ++bj)
#pragma unroll
                            for (int n = 0; n < 2; ++n) *(u32x2*)(dst + 128 * bj + 16 * n) = pack4(z[bj][n] * sc);
                    } else if (pn <= 10) {
                        const int cb = (pn - 9) * 256 + 32 * wc + 8 * fq;
#pragma unroll
                        for (int bj = 0; bj < 2; ++bj) { *(u32x4*)(V + (size_t)r * 512 + cb + 128 * bj) = pack8(z[bj][0], z[bj][1]);
                            if (!smp) { float* o = out + OUT_NV + newkv_off(r, l, cb + 128 * bj); *(f32x4*)o = z[bj][0]; *(f32x4*)(o + 4) = z[bj][1]; } }
                    } else {
                        const int cb = (pn - 11) * 256 + 32 * wc + 8 * fq;
#pragma unroll
                        for (int bj = 0; bj < 2; ++bj) *(u32x4*)(SGC + (size_t)r * 512 + cb + 128 * bj) = pack8(silu4(z[bj][0]), silu4(z[bj][1]));
                    }
                    asm volatile("" ::: "memory");
                }
        } else {
            const int sp = u.pm, pn = u.pn, bb = modid(pn * 256);
            f32x4 rs[2][2];
#pragma unroll
            for (int bj = 0; bj < 2; ++bj)
#pragma unroll
                for (int n = 0; n < 2; ++n) rs[bj][n] = *(const LAS f32x4*)(RT + u.aux * 256 + 128 * bj + 32 * wc + 16 * n + 4 * fq);
            u16* base; size_t rowstride;
            if (pn < 16) { base = XTC + (size_t)pn * 256 * 512 + sp * 256; rowstride = 512; }
            else { const int b = (pn - 16) >> 3; base = XTS + (size_t)b * 256 * 4096 + sp * 2048 + ((pn - 16) & 7) * 256; rowstride = 4096; }
#pragma unroll
            for (int ai = 0; ai < 2; ++ai)
#pragma unroll
                for (int m = 0; m < 4; ++m) { const int ch = 128 * ai + 64 * wr + 16 * m + fr; const float sw = SWF[bb * NFT + sp * 256 + ch]; u16* rowp = base + (size_t)ch * rowstride + 32 * wc + 4 * fq;
#pragma unroll
                    for (int bj = 0; bj < 2; ++bj)
#pragma unroll
                        for (int n = 0; n < 2; ++n) *(u32x2*)(rowp + 128 * bj + 16 * n) = pack4(acc[ai][bj][m][n] * rs[bj][n] + sw);
                    asm volatile("" ::: "memory"); }
        }
    }
};
struct SchedP1 {
    const char *AP, *WM, *WF; int G, c;
    __device__ __forceinline__ bool next(int i, Unit& u) const {
        const int L = i * G + c; if (L >= 720) return false;
        constexpr size_t TSTEP = (size_t)256 * DM * 2;
        if (L < 624) { const int wgid = (L % 8) * 78 + L / 8; const int gid = wgid / 104, w = wgid % 104; u.kind = 0; u.pm = gid * 8 + (w % 8); u.pn = w / 8; u.A = AP + (size_t)u.pm * TSTEP; u.B = WM + (size_t)u.pn * TSTEP; }
        else { const int idx = L - 624; u.kind = 1; u.pm = idx / 48; u.pn = idx % 48; u.A = WF + (size_t)u.pm * TSTEP; u.B = AP + (size_t)u.pn * TSTEP; }
        u.aux = i; return true;
    }
    __device__ __forceinline__ void a_ready(const Unit&) const {}
    __device__ __forceinline__ void done(const Unit&) const {}
};

struct EpiOut {
    static constexpr bool PERM = false, AFTER_DRAIN = false;
    const float *MOD, *xp, *xs, *norm_g1; float *X1, *PART, *out; u16* AP; int l;
    __device__ __forceinline__ void operator()(const Acc& acc, const Unit& u, int wr, int wc, int fr, int fq) const {
        asm volatile("" : "+v"(fr), "+v"(fq));
        const int pm = u.pm, pn = u.pn, bb = modid(pm * 256), c0 = pn * 256 + 32 * wc + 4 * fq;
        f32x4 gate[2][2], gs[2][2];
#pragma unroll
        for (int bj = 0; bj < 2; ++bj)
#pragma unroll
            for (int n = 0; n < 2; ++n) { const int c = c0 + 128 * bj + 16 * n; gate[bj][n] = *(const f32x4*)(MOD + (l * 5 + bb) * 3072 + 2048 + c);
                if (l == 0) { const f32x4 g = *(const f32x4*)(norm_g1 + c), s = *(const f32x4*)(MOD + (5 + bb) * 3072 + 1024 + c); gs[bj][n] = g * (1.f + s); } }
#pragma unroll
        for (int ai = 0; ai < 2; ++ai)
#pragma unroll
            for (int m = 0; m < 4; ++m) {
                const int r = pm * 256 + 128 * ai + 64 * wr + 16 * m + fr;
                const float* xo = l == 0 ? (r < NCTX ? xp + (size_t)r * DM : xs + (size_t)(r - NCTX) * DM) : X1 + (size_t)r * DM;
                float* xn = l == 0 ? X1 + (size_t)r * DM : out + (size_t)r * DM;
                float ss = 0;
#pragma unroll
                for (int bj = 0; bj < 2; ++bj)
#pragma unroll
                    for (int n = 0; n < 2; ++n) { const int c = c0 + 128 * bj + 16 * n; const f32x4 v = *(const f32x4*)(xo + c) + gate[bj][n] * acc[ai][bj][m][n];
                        ss += (v[0] * v[0] + v[1] * v[1]) + (v[2] * v[2] + v[3] * v[3]); *(f32x4*)(xn + c) = v;
                        if (l == 0) *(u32x2*)(AP + (size_t)r * DM + c) = pack4(v * gs[bj][n]); }
                ss += __shfl_xor(ss, 16); ss += __shfl_xor(ss, 32);
                if (fq == 0) PART[(size_t)r * 16 + pn * 4 + wc] = ss;
                asm volatile("" ::: "memory");
            }
    }
};
struct SchedP3 {
    const char *Y, *WO; int G, c;
    __device__ __forceinline__ bool next(int i, Unit& u) const {
        const int L = i * G + c; if (L >= 192) return false;
        constexpr size_t TSTEP = (size_t)256 * DM * 2;
        const int wgid = (L % 8) * 24 + L / 8; const int gid = wgid / 32, w = wgid % 32; u.kind = 0; u.pm = gid * 8 + (w % 8); u.pn = w / 8; u.A = Y + (size_t)u.pm * TSTEP; u.B = WO + (size_t)u.pn * TSTEP; u.aux = 0; return true;
    }
    __device__ __forceinline__ void a_ready(const Unit&) const {}
    __device__ __forceinline__ void done(const Unit&) const {}
};

struct EpiFourier {
    static constexpr bool PERM = true, AFTER_DRAIN = false;
    const u16* SGA; u16* Y;
    __device__ __forceinline__ void operator()(const Acc& acc, const Unit& u, int wr, int wc, int fr, int fq) const {
        asm volatile("" : "+v"(fr), "+v"(fq));
#pragma unroll
        for (int ai = 0; ai < 2; ++ai)
#pragma unroll
            for (int m = 0; m < 4; ++m) { const int r = u.aux + 128 * ai + 64 * wr + 16 * m + fr;
#pragma unroll
                for (int bj = 0; bj < 2; ++bj) { const int c = 128 * bj + 32 * wc + 8 * fq; const u32x4 g = *(const u32x4*)(SGA + (size_t)r * 256 + c);
                    const f32x4 a = acc[ai][bj][m][0], b = acc[ai][bj][m][1];
                    u32x4 w; w.x = pk2(a[0] * bflo(g.x), a[1] * bfhi(g.x)); w.y = pk2(a[2] * bflo(g.y), a[3] * bfhi(g.y)); w.z = pk2(b[0] * bflo(g.z), b[1] * bfhi(g.z)); w.w = pk2(b[2] * bflo(g.w), b[3] * bfhi(g.w));
                    *(u32x4*)(Y + (size_t)r * DM + c) = w; } }
    }
};
struct SchedOne {
    Unit u0;
    __device__ __forceinline__ bool next(int i, Unit& u) const { if (i > 0) return false; u = u0; return true; }
    __device__ __forceinline__ void a_ready(const Unit&) const {}
    __device__ __forceinline__ void done(const Unit&) const {}
};

__device__ __forceinline__ void phase_final(const Ctx& C) {
    const float* PART = WSP(float, WS_PART);
    for (long i = (long)C.bid * 512 + C.tid; i < (long)NTOK * 256; i += (long)C.G * 512) { const int r = (int)(i >> 8), c = (int)(i & 255) * 4; const float rs = row_rstd(PART, r);
        f32x4* p = (f32x4*)(C.out + (size_t)r * DM + c); *p = *p * rs * *(const f32x4*)(C.final_g + c); }
}
#ifndef FAST_P1
#define FAST_P1 1
#endif
#ifndef FAST_P3
#define FAST_P3 1
#endif
#ifndef FAST_ATTN
#define FAST_ATTN 1
#endif
#ifndef FAST_FOUR
#define FAST_FOUR 1
#endif
constexpr int IT_FS = 0, IT_AS = 32, IT_AC = 288, IT_FC = 416, IT_CV = 432, IT_END = 480;
__device__ __forceinline__ void phase_mix(const Ctx& C, int l, volatile LAS unsigned* MISC) {
    unsigned* head = WSP(unsigned, WS_CTL) + CW_QUEUE + 64 * l;
    const float lam = WSP(float, WS_LAM)[l], post = 1.f - (0.8f - 0.6f * expf(-0.3f * (float)l));
    for (;;) {
        if (C.tid == 0) MISC[16] = __hip_atomic_fetch_add(head, 1u, __ATOMIC_RELAXED, __HIP_MEMORY_SCOPE_AGENT);
        __syncthreads();
        const int item = (int)MISC[16];
        __syncthreads();
        if (item >= IT_END) break;
        if (item < IT_AS || (item >= IT_FC && item < IT_CV)) {
#if FAST_FOUR
            SchedOne S; int K;
            if (item < IT_AS) { const int b = item >> 3, mt = item & 7; K = 4096; S.u0.A = (const char*)(WSP(u16, WS_DS) + (size_t)mt * 256 * 4096); S.u0.B = (const char*)(WSP(u16, WS_XTS) + (size_t)b * 256 * 4096); S.u0.aux = NCTX + b * 2048 + mt * 256; }
            else { const int b = item - IT_FC; K = 512; S.u0.A = (const char*)WSP(u16, WS_DC); S.u0.B = (const char*)(WSP(u16, WS_XTC) + (size_t)b * 256 * 512); S.u0.aux = b * 256; }
            S.u0.kind = 0; S.u0.pm = 0; S.u0.pn = 0;
            EpiFourier E{WSP(u16, WS_SGA), WSP(u16, WS_YMIX)};
            pg8::gemm_phase<EpiFourier, SchedOne, true, true>(C.lds, K, S, E);
            __syncthreads();
#endif
        } else if (item < IT_FC) {
#if FAST_ATTN
            attn::Item it; int r0, h;
            if (item < IT_AC) { const int a = item - IT_AS, b = a >> 6, qb = a & 15; h = (a >> 4) & 3; r0 = NCTX + b * 2048 + qb * 128; it.nc = 512; it.seq = 2560;
                it.Kc = WSP(u16, WS_CK) + ((size_t)(l * 4 + b) * 512) * 512 + h * 128; it.Vc = WSP(u16, WS_CV) + ((size_t)(l * 4 + b) * 512) * 512 + h * 128;
                it.Kn = WSP(u16, WS_K) + (size_t)(NCTX + b * 2048) * 512 + h * 128; it.Vn = WSP(u16, WS_V) + (size_t)(NCTX + b * 2048) * 512 + h * 128; }
            else { const int a = item - IT_AC, b = a >> 3, qb = a & 1; h = (a >> 1) & 3; r0 = b * 256 + qb * 128; it.nc = 0; it.seq = 256; it.Kc = it.Vc = nullptr;
                it.Kn = WSP(u16, WS_K) + (size_t)(b * 256) * 512 + h * 128; it.Vn = WSP(u16, WS_V) + (size_t)(b * 256) * 512 + h * 128; }
            it.Q = WSP(u16, WS_Q) + (size_t)r0 * 512 + h * 128; it.SGC = WSP(u16, WS_SGC) + (size_t)r0 * 512 + h * 128; it.Y = WSP(u16, WS_YMIX) + (size_t)r0 * DM + 512 + h * 128;
            it.subln = C.subln_g + l * 128; it.lam = lam; it.post = post;
            attn::diff_attn_item(it, C.lds);
#endif
        } else {
            const int ci = item - IT_CV; conv_items(C, l, (long)ci * 8192 + C.tid, 512, (long)(ci + 1) * 8192);
        }
    }
}

__global__ void __launch_bounds__(512, 2) mk_fwd(Args a) {
    extern __shared__ __attribute__((aligned(16))) unsigned char lds[];
    Ctx C;
    C.x_prompt = a.in[0]; C.x_sample = a.in[1]; C.cache_k = a.in[2]; C.cache_v = a.in[3]; C.c = a.in[4]; C.c_ctx = a.in[5]; C.norm_g = a.in[6]; C.w_mod = a.in[7];
    C.b_mod = a.in[8]; C.w_in = a.in[9]; C.conv_w = a.in[10]; C.conv_b = a.in[11]; C.lam_vec = a.in[12]; C.subln_g = a.in[13]; C.w_out = a.in[14]; C.final_g = a.in[15];
    C.out = a.out; C.ws = a.ws; C.lds = (LAS unsigned char*)lds;
    C.tid = threadIdx.x; C.lane = C.tid & 63; C.wave = __builtin_amdgcn_readfirstlane(C.tid >> 6); C.G = gridDim.x; C.bid = blockIdx.x;
    volatile LAS unsigned* MISC = (volatile LAS unsigned*)(C.lds + MISC_OFF);
    if (C.tid < 32) MISC[C.tid] = 0u;
    __syncthreads();
    XcdBarrier bar = xcd_barrier_post(WSP(unsigned, WS_CTL) + CW_BAR, MISC + 8);
#define GRID_BAR() do { xcd_barrier(bar); asm volatile("" : "+v"(C.tid), "+v"(C.lane)); } while (0)
    phase_p0a(C); GRID_BAR();
    phase_p0b(C); GRID_BAR();
#pragma unroll 1
    for (int l = 0; l < 2; ++l) {
#if FAST_P1
        { SchedP1 S{(const char*)WSP(u16, WS_AP), (const char*)(WSP(u16, WS_WMT) + (size_t)l * NMAIN * DM), (const char*)(WSP(u16, WS_WFT) + (size_t)l * NFT * DM), C.G, C.bid};
          LAS float* RT = (LAS float*)(C.lds + RSTD_OFF);
          for (int i = 0; i < 3; ++i) { Unit u; if (!S.next(i, u)) break; if (C.tid < 256) RT[i * 256 + C.tid] = row_rstd(WSP(float, WS_PART), (u.kind == 0 ? u.pm : u.pn) * 256 + C.tid); }
          __syncthreads();
          EpiInProj E{RT, WSP(float, WS_SW) + l * 5 * NMAIN, WSP(float, WS_SWF) + l * 5 * NFT, WSP(f32x2, WS_ROPE), WSP(u16, WS_SGA), WSP(u16, WS_U), WSP(u16, WS_WC), WSP(u16, WS_Q), WSP(u16, WS_K), WSP(u16, WS_V),
                      WSP(u16, WS_SGC), WSP(u16, WS_XTS), WSP(u16, WS_XTC), C.out, l};
          pg8::gemm_phase<EpiInProj, SchedP1, true, true>(C.lds, DM, S, E); }
#else
        naive_p1(C, l);
#endif
        GRID_BAR();
#if !FAST_FOUR
        naive_fourier(C);
#endif
#if !FAST_ATTN
        naive_attn(C, l);
#endif
        phase_mix(C, l, MISC);
        GRID_BAR();
#if FAST_P3
        { SchedP3 S{(const char*)WSP(u16, WS_YMIX), (const char*)(WSP(u16, WS_WOT) + (size_t)l * DM * DM), C.G, C.bid};
          EpiOut E{WSP(float, WS_MOD), C.x_prompt, C.x_sample, C.norm_g + DM, WSP(float, WS_X1), WSP(float, WS_PART), C.out, WSP(u16, WS_AP), l};
          pg8::gemm_phase<EpiOut, SchedP3, true, true>(C.lds, DM, S, E); }
        GRID_BAR();
#else
        naive_p3(C, l); if (l == 0) GRID_BAR();
#endif
    }
#if FAST_P3
    phase_final(C);
#endif
}

extern "C" void kernel_launch(void* const* d_in, const int* in_sizes, int n_in, void* d_out, int out_size, void* d_ws, size_t ws_size, hipStream_t stream) {
    static int grid = 0;
    if (grid == 0) {
        if (n_in != 16 || out_size != (int)OUT_TOTAL || ws_size < WS_END) { fprintf(stderr, "kernel_launch: unexpected shapes (n_in %d out %d ws %zu)\n", n_in, out_size, ws_size); grid = -1; return; }
        int dev = 0, cus = 0, per_cu = 0;
        if (hipGetDevice(&dev) != hipSuccess || hipDeviceGetAttribute(&cus, hipDeviceAttributeMultiprocessorCount, dev) != hipSuccess) { grid = -1; return; }
        if (hipFuncSetAttribute((const void*)mk_fwd, hipFuncAttributeMaxDynamicSharedMemorySize, LDS_BYTES) != hipSuccess) { fprintf(stderr, "kernel_launch: hipFuncSetAttribute failed\n"); grid = -1; return; }
        if (hipOccupancyMaxActiveBlocksPerMultiprocessor(&per_cu, (const void*)mk_fwd, 512, LDS_BYTES) != hipSuccess || per_cu < 1) { fprintf(stderr, "kernel_launch: occupancy query says %d blocks/CU\n", per_cu); (void)hipGetLastError(); grid = -1; return; }
        grid = cus;
    }
    if (grid < 0) return;
    if (hipMemsetAsync((char*)d_ws + WS_CTL, 0, 1u << 20, stream) != hipSuccess) return;
    Args a{};
    for (int i = 0; i < 16; ++i) a.in[i] = (const float*)d_in[i];
    a.out = (float*)d_out; a.ws = (unsigned char*)d_ws; a.ph_lo = 0; a.ph_hi = 99;
    hipLaunchKernelGGL(mk_fwd, dim3(grid), dim3(512), LDS_BYTES, stream, a);
}
```
